# Optimizing an MI355X kernel written in HIP

```python
import jax, jax.numpy as jnp
from jax import lax
import numpy as np

D_MODEL = 1024
BATCH = 8
SEQ = 8192
DEPTH = 2

MEM_LEN = 256
HEAD_DIM = 64
ROPE_THETA = 10000.0
NORM_EPS = 1e-6
BLOCK = 128

SWA_HEADS = 8
SWA_KV_HEADS = 2
SWA_WINDOW = 128
MLA_HEADS = 8
MLA_Q_RANK = 384
MLA_KV_RANK = 256
MLA_NOPE_DIM = 64
MLA_ROPE_DIM = 32
MLA_V_DIM = 64
A_Q = SWA_HEADS * HEAD_DIM
A_KV = SWA_KV_HEADS * HEAD_DIM
EVEN_IN = A_Q + 2 * A_KV + MLA_Q_RANK + MLA_KV_RANK + MLA_ROPE_DIM
EVEN_SPLITS = [A_Q, A_Q + A_KV, A_Q + 2 * A_KV, A_Q + 2 * A_KV + MLA_Q_RANK,
               A_Q + 2 * A_KV + MLA_Q_RANK + MLA_KV_RANK]
EVEN_OUT = SWA_HEADS * HEAD_DIM + MLA_HEADS * MLA_V_DIM
DIL_HEADS = D_MODEL // HEAD_DIM
DIL_PATTERNS = ((128, 1), (512, 4), (2048, 16))
X_HEADS = 4
X_HEAD_DIM = 128
FFN_HIDDEN = -(-8 * D_MODEL // (3 * 256)) * 256

kernel_name = 'hybrid_swa_mla_dilated_block'


def rms_norm(x, g):
    xf = x.astype(jnp.float32)
    y = xf * lax.rsqrt(jnp.mean(xf * xf, axis=-1, keepdims=True) + NORM_EPS)
    return (y * g.astype(jnp.float32)).astype(x.dtype)


def rope(x, positions):
    dh = x.shape[-1]
    inv_freq = ROPE_THETA ** (-jnp.arange(0, dh, 2, dtype=jnp.float32) / dh)
    ang = positions.astype(jnp.float32)[..., None] * inv_freq
    c = jnp.cos(ang)[:, :, None, :]
    s = jnp.sin(ang)[:, :, None, :]
    x1, x2 = jnp.split(x.astype(jnp.float32), 2, axis=-1)
    return jnp.concatenate([x1 * c - x2 * s, x2 * c + x1 * s], axis=-1).astype(x.dtype)


def banded_attention(q, k, v, max_dist, sink=None):
    b, L, h, dh = q.shape
    g = k.shape[2]
    rep = h // g
    nb = L // BLOCK
    qb = q.reshape(b, nb, BLOCK, g, rep, dh)

    def two_blocks(t):
        tb = t.reshape(b, nb, BLOCK, g, t.shape[-1])
        prev = jnp.pad(tb, ((0, 0), (1, 0), (0, 0), (0, 0), (0, 0)))[:, :-1]
        return jnp.concatenate([prev, tb], axis=2)

    kk = two_blocks(k)
    vv = two_blocks(v)
    s = jnp.einsum('bnqgrd,bnkgd->bngrqk', qb, kk).astype(jnp.float32) * (dh ** -0.5)
    qi = jnp.arange(BLOCK)[:, None]
    kj = jnp.arange(2 * BLOCK)[None, :]
    dist = BLOCK + qi - kj
    band = (dist >= 0) & (dist <= max_dist)
    exists = (jnp.arange(nb)[:, None, None] > 0) | (kj >= BLOCK)[None]
    mask = band[None] & exists
    s = jnp.where(mask[None, :, None, None], s, -jnp.inf)
    m = jnp.max(s, axis=-1, keepdims=True)
    if sink is not None:
        sk = sink.astype(jnp.float32).reshape(g, rep)[None, None, :, :, None, None]
        m = jnp.maximum(m, sk)
    p = jnp.exp(s - m)
    l = jnp.sum(p, axis=-1, keepdims=True)
    if sink is not None:
        l = l + jnp.exp(sk - m)
    o = jnp.einsum('bngrqk,bnkgd->bnqgrd', (p / l).astype(v.dtype), vv)
    lse = (m + jnp.log(l))[..., 0].transpose(0, 1, 4, 2, 3).reshape(b, L, h)
    return o.reshape(b, L, h, -1), lse


def causal_mla_attention(q_nope, q_rope, k_nope, k_rope, v):
    S = q_nope.shape[1]
    scale = (q_nope.shape[-1] + q_rope.shape[-1]) ** -0.5
    outs = []
    for i in range(S // BLOCK):
        q0, q1 = i * BLOCK, (i + 1) * BLOCK
        s = (jnp.einsum('bqhd,bkhd->bhqk', q_nope[:, q0:q1], k_nope[:, :q1])
             + jnp.einsum('bqhd,bkd->bhqk', q_rope[:, q0:q1], k_rope[:, :q1])).astype(jnp.float32) * scale
        causal = jnp.arange(q0, q1)[:, None] >= jnp.arange(q1)[None, :]
        p = jax.nn.softmax(jnp.where(causal, s, -jnp.inf), axis=-1).astype(v.dtype)
        outs.append(jnp.einsum('bhqk,bkhd->bqhd', p, v[:, :q1]))
    return jnp.concatenate(outs, axis=1)


def even_mixer(h, positions, w_in, sinks, q_norm, w_uq, kv_norm, w_ukv, w_out):
    b, s, _ = h.shape
    z = h @ w_in
    qa, ka, va, cq, ckv, kr = jnp.split(z, EVEN_SPLITS, axis=-1)
    qa = rope(qa.reshape(b, s, SWA_HEADS, HEAD_DIM), positions)
    ka = rope(ka.reshape(b, s, SWA_KV_HEADS, HEAD_DIM), positions)
    va = va.reshape(b, s, SWA_KV_HEADS, HEAD_DIM)
    oa, _ = banded_attention(qa, ka, va, SWA_WINDOW - 1, sink=sinks)
    qb = (rms_norm(cq, q_norm) @ w_uq).reshape(b, s, MLA_HEADS, MLA_NOPE_DIM + MLA_ROPE_DIM)
    q_nope, q_rope = jnp.split(qb, [MLA_NOPE_DIM], axis=-1)
    q_rope = rope(q_rope, positions)
    kvb = (rms_norm(ckv, kv_norm) @ w_ukv).reshape(b, s, MLA_HEADS, MLA_NOPE_DIM + MLA_V_DIM)
    k_nope, vb = jnp.split(kvb, [MLA_NOPE_DIM], axis=-1)
    k_rope = rope(kr[:, :, None, :], positions)[:, :, 0]
    ob = causal_mla_attention(q_nope, q_rope, k_nope, k_rope, vb)
    o = jnp.concatenate([oa.reshape(b, s, -1), ob.reshape(b, s, -1)], axis=-1)
    return o @ w_out


def dilated_attention(q, k, v):
    b, s, h, dh = q.shape
    outs, lses = [], []
    for window, dil in DIL_PATTERNS:
        span = dil * BLOCK
        L = -(-s // span) * span
        n = L // dil

        def deinterleave(t):
            t = jnp.pad(t, ((0, 0), (0, L - s), (0, 0), (0, 0)))
            return t.reshape(b, n, dil, h, dh).transpose(0, 2, 1, 3, 4).reshape(b * dil, n, h, dh)

        o, lse = banded_attention(deinterleave(q), deinterleave(k), deinterleave(v), window // dil)
        outs.append(o.reshape(b, dil, n, h, dh).transpose(0, 2, 1, 3, 4).reshape(b, L, h, dh)[:, :s])
        lses.append(lse.reshape(b, dil, n, h).transpose(0, 2, 1, 3).reshape(b, L, h)[:, :s])
    wts = jax.nn.softmax(jnp.stack(lses, axis=-1), axis=-1).astype(q.dtype)
    return jnp.einsum('bshdn,bshn->bshd', jnp.stack(outs, axis=-1), wts)


def odd_mixer(h, positions, w_qkv, w_out):
    b, s, _ = h.shape
    q, k, v = jnp.split((h @ w_qkv).reshape(b, s, 3 * DIL_HEADS, HEAD_DIM), 3, axis=2)
    o = dilated_attention(rope(q, positions), rope(k, positions), v)
    return o.reshape(b, s, -1) @ w_out


def memory_cross_attention(h, mem_n, w_q, w_kv, w_o):
    b, s, _ = h.shape
    q = (h @ w_q).reshape(b, s, X_HEADS, X_HEAD_DIM)
    k, v = jnp.split((mem_n @ w_kv).reshape(b, mem_n.shape[1], 2 * X_HEADS, X_HEAD_DIM), 2, axis=2)
    sc = jnp.einsum('bqhd,bkhd->bhqk', q, k).astype(jnp.float32) * (X_HEAD_DIM ** -0.5)
    p = jax.nn.softmax(sc, axis=-1).astype(v.dtype)
    o = jnp.einsum('bhqk,bkhd->bqhd', p, v).reshape(b, s, -1)
    return o @ w_o


def swiglu(h, w_gate, w_up, w_down):
    return (jax.nn.silu(h @ w_gate) * (h @ w_up)) @ w_down


def setup_inputs(seed: int = 0) -> dict:
    key = jax.random.key(seed)
    keys = iter(jax.random.split(key, 64))

    def w(shape, fan_in, gain=1.0):
        return jax.random.normal(next(keys), shape, jnp.float32) * (gain * fan_in ** -0.5)

    def gain_vec(n):
        return 1.0 + 0.02 * jax.random.normal(next(keys), (n,), jnp.float32)

    res_gain = (2.0 * DEPTH) ** -0.5
    inp = {}
    inp['x'] = jax.random.normal(next(keys), (BATCH, SEQ, D_MODEL), jnp.float32)
    inp['mem'] = jax.random.normal(next(keys), (BATCH, MEM_LEN, D_MODEL), jnp.float32)
    offsets = jax.random.randint(next(keys), (BATCH, 1), 0, 4096, dtype=jnp.int32)
    inp['positions'] = jnp.arange(SEQ, dtype=jnp.int32)[None, :] + offsets
    for l in range(DEPTH):
        p = 'l%d_' % l
        inp[p + 'mix_norm'] = gain_vec(D_MODEL)
        if l % 2 == 0:
            inp[p + 'w_in'] = w((D_MODEL, EVEN_IN), D_MODEL)
            inp[p + 'sinks'] = jax.random.normal(next(keys), (SWA_HEADS,), jnp.float32)
            inp[p + 'q_norm'] = gain_vec(MLA_Q_RANK)
            inp[p + 'w_uq'] = w((MLA_Q_RANK, MLA_HEADS * (MLA_NOPE_DIM + MLA_ROPE_DIM)), MLA_Q_RANK)
            inp[p + 'kv_norm'] = gain_vec(MLA_KV_RANK)
            inp[p + 'w_ukv'] = w((MLA_KV_RANK, MLA_HEADS * (MLA_NOPE_DIM + MLA_V_DIM)), MLA_KV_RANK)
            inp[p + 'w_out'] = w((EVEN_OUT, D_MODEL), EVEN_OUT, res_gain)
        else:
            inp[p + 'w_qkv'] = w((D_MODEL, 3 * DIL_HEADS * HEAD_DIM), D_MODEL)
            inp[p + 'w_out'] = w((DIL_HEADS * HEAD_DIM, D_MODEL), DIL_HEADS * HEAD_DIM, res_gain)
        inp[p + 'x_norm'] = gain_vec(D_MODEL)
        inp[p + 'mem_norm'] = gain_vec(D_MODEL)
        inp[p + 'w_xq'] = w((D_MODEL, X_HEADS * X_HEAD_DIM), D_MODEL)
        inp[p + 'w_xkv'] = w((D_MODEL, 2 * X_HEADS * X_HEAD_DIM), D_MODEL)
        inp[p + 'w_xo'] = w((X_HEADS * X_HEAD_DIM, D_MODEL), X_HEADS * X_HEAD_DIM, res_gain)
        inp[p + 'ffn_norm'] = gain_vec(D_MODEL)
        inp[p + 'w_gate'] = w((D_MODEL, FFN_HIDDEN), D_MODEL)
        inp[p + 'w_up'] = w((D_MODEL, FFN_HIDDEN), D_MODEL)
        inp[p + 'w_down'] = w((FFN_HIDDEN, D_MODEL), FFN_HIDDEN, res_gain)
    inp['final_norm'] = gain_vec(D_MODEL)
    return inp


def reference(x, mem, positions,
              l0_mix_norm, l0_w_in, l0_sinks, l0_q_norm, l0_w_uq, l0_kv_norm, l0_w_ukv, l0_w_out,
              l0_x_norm, l0_mem_norm, l0_w_xq, l0_w_xkv, l0_w_xo,
              l0_ffn_norm, l0_w_gate, l0_w_up, l0_w_down,
              l1_mix_norm, l1_w_qkv, l1_w_out,
              l1_x_norm, l1_mem_norm, l1_w_xq, l1_w_xkv, l1_w_xo,
              l1_ffn_norm, l1_w_gate, l1_w_up, l1_w_down,
              final_norm):
    mixers = [
        lambda h: even_mixer(h, positions, l0_w_in, l0_sinks, l0_q_norm, l0_w_uq,
                             l0_kv_norm, l0_w_ukv, l0_w_out),
        lambda h: odd_mixer(h, positions, l1_w_qkv, l1_w_out),
    ]
    mix_norms = [l0_mix_norm, l1_mix_norm]
    xattn = [(l0_x_norm, l0_mem_norm, l0_w_xq, l0_w_xkv, l0_w_xo),
             (l1_x_norm, l1_mem_norm, l1_w_xq, l1_w_xkv, l1_w_xo)]
    ffns = [(l0_ffn_norm, l0_w_gate, l0_w_up, l0_w_down),
            (l1_ffn_norm, l1_w_gate, l1_w_up, l1_w_down)]
    for layer in range(DEPTH):
        x = x + mixers[layer](rms_norm(x, mix_norms[layer]))
        xn, mn, wq, wkv, wo = xattn[layer]
        x = x + memory_cross_attention(rms_norm(x, xn), rms_norm(mem, mn), wq, wkv, wo)
        fn, wg, wu, wd = ffns[layer]
        x = x + swiglu(rms_norm(x, fn), wg, wu, wd)
    return rms_norm(x, final_norm)
```

```cpp
#include <hip/hip_runtime.h>
#include <hip/hip_cooperative_groups.h>
#include <cstdio>
#include <cstdint>
#include <cmath>
namespace cg = cooperative_groups;

#define LAS __attribute__((address_space(3)))
#define GAS __attribute__((address_space(1)))
#define DI __device__ __forceinline__
typedef unsigned short bf16_t;
typedef short bf16x8 __attribute__((ext_vector_type(8)));
typedef short s16x4 __attribute__((ext_vector_type(4)));
typedef float f32x2 __attribute__((ext_vector_type(2)));
typedef float f32x4 __attribute__((ext_vector_type(4)));
typedef float f32x16 __attribute__((ext_vector_type(16)));
typedef unsigned u32x2 __attribute__((ext_vector_type(2)));
typedef unsigned u32x4 __attribute__((ext_vector_type(4)));
typedef __bf16 bf16x2_t __attribute__((ext_vector_type(2)));

constexpr int NB = 8, S = 8192, T = NB * S, D = 1024, MEMLEN = 256, MROWS = NB * MEMLEN;
constexpr int ZP = 1536;
constexpr int Z_KA = 512, Z_VA = 640, Z_CQ = 768, Z_CKV = 1152, Z_KR = 1408;
constexpr int FF = 2816;
constexpr float EPS = 1e-6f;
constexpr float LOG2E = 1.4426950408889634f;

constexpr size_t MiB = 1u << 20;
constexpr size_t W_IN = 1, W_UQ = 4, W_UKV = 5, W_OUT0 = 6, W_XQ0 = 8, W_XKV = 9, W_XO0 = 13, W_GU0 = 14, W_DN0 = 25,
                 W_QKV = 31, W_OUT1 = 37, W_XQ1 = 39, W_XO1 = 40, W_GU1 = 41, W_DN1 = 52,
                 O_R64C = 58, O_R64S = 66, O_R32C = 74, O_R32S = 78, O_SSQ = 82, O_SSQQ = 86, O_SSQKV = 90, O_MEMSSQ = 94,
                 O_MEMB = 95, O_MEMKV = 99, O_LSE1 = 107, O_LSE2 = 111, O_XB = 116, O_BIG = 244, O_R1 = 628, O_R2 = 756, O_OB = 884,
                 WS_NEED = 1012;

DI unsigned cvtpk(float lo, float hi) { f32x2 v = {lo, hi}; bf16x2_t b = __builtin_convertvector(v, bf16x2_t); return __builtin_bit_cast(unsigned, b); }
DI float bflo(unsigned u) { return __uint_as_float(u << 16); }
DI float bfhi(unsigned u) { return __uint_as_float(u & 0xffff0000u); }
DI float bf2f(bf16_t h) { return __uint_as_float(((unsigned)h) << 16); }
DI bf16_t f2bf(float f) { return (bf16_t)(cvtpk(f, 0.f) & 0xffffu); }
DI float wave_sum(float v) {
#pragma unroll
    for (int o = 1; o < 64; o <<= 1) v += __shfl_xor(v, o);
    return v;
}

namespace pg8 {
constexpr int BM = 256, BK = 64, HALF = 128, HTB = HALF * BK * 2, NXCD = 8, WGM = 8;
DI int lds_byte(int r, int c) { const int st = (r >> 4) * 2 + (c >> 5), rr = r & 15, cc = c & 31, ob = rr * 64 + cc * 2; return st * 1024 + (ob ^ (((ob >> 9) & 1) << 5)); }
DI void stage_rc(int b, int& R, int& C) { const int st = b / 1024, sb = b % 1024, swz = sb ^ (((sb >> 9) & 1) << 5); R = (st >> 1) * 16 + swz / 64; C = (st & 1) * 32 + (swz % 64) / 2; }
DI int perm32(int rho) { const int n = rho >> 4, i = rho & 15; return 8 * (i >> 2) + 4 * n + (i & 3); }
struct Unit { int pm, pn; };
struct Gemm { const GAS bf16_t* A; const GAS bf16_t* Bt; int M, N, K, lda; };
struct StaticOrder {
    int nM, nN, nwg, G, c;
    DI void init(int M, int N, int G_, int c_) { nM = M / BM; nN = N / BM; nwg = nM * nN; G = G_; c = c_; }
    DI bool next(int i, Unit& u) const {
        const long L = (long)i * G + c; if (L >= nwg) return false;
        int wgid = (int)L; { const int q = nwg / NXCD, r = nwg % NXCD, xcd = wgid % NXCD, off = wgid / NXCD; wgid = (xcd < r ? xcd * (q + 1) : r * (q + 1) + (xcd - r) * q) + off; }
        const int nig = WGM * nN, gid = wgid / nig, fm = gid * WGM, gsz = (nM - fm) < WGM ? (nM - fm) : WGM;
        u.pm = fm + ((wgid % nig) % gsz); u.pn = (wgid % nig) / gsz; return true;
    }
};

typedef _Float16 f16x4 __attribute__((ext_vector_type(4)));
struct EpiP { GAS bf16_t* O; int ldc; const GAS float* ssq; float inv_dim; const GAS float* Xin; GAS float* Xout; GAS bf16_t* XB; GAS float* ssq_out; GAS _Float16* X16; const GAS float* rc; const GAS float* rs; int rope_lo, rope_hi; };

DI float row_rstd(const GAS float* ssq, float inv_dim, int row) {
    const GAS f32x4* p = (const GAS f32x4*)(ssq + (size_t)row * 16);
    const f32x4 a = p[0], b = p[1], c = p[2], d = p[3];
    const float s = ((a[0] + a[1]) + (a[2] + a[3])) + ((b[0] + b[1]) + (b[2] + b[3])) + ((c[0] + c[1]) + (c[2] + c[3])) + ((d[0] + d[1]) + (d[2] + d[3]));
    return __builtin_amdgcn_rsqf(s * inv_dim + EPS);
}
DI void rows_rstd(const GAS float* ssq, float inv_dim, int row0, int fq, float (&rs)[2][4]) {
    f32x4 pr[2][4];
#pragma unroll
    for (int ai = 0; ai < 2; ++ai)
#pragma unroll
        for (int m = 0; m < 4; ++m) pr[ai][m] = *(const GAS f32x4*)(ssq + (size_t)(row0 + ai * HALF + m * 16) * 16 + 4 * fq);
#pragma unroll
    for (int ai = 0; ai < 2; ++ai)
#pragma unroll
        for (int m = 0; m < 4; ++m) { float s = (pr[ai][m][0] + pr[ai][m][1]) + (pr[ai][m][2] + pr[ai][m][3]); s += __shfl_xor(s, 16); s += __shfl_xor(s, 32); rs[ai][m] = __builtin_amdgcn_rsqf(s * inv_dim + EPS); }
}
struct EpiScale {
    static constexpr bool PERM = true; EpiP p;
    DI void operator()(const f32x4 (&acc)[2][2][4][2], const Unit& u, int wr, int wc, int fr, int fq) const {
        const int row0 = u.pm * BM + wr * 64 + fr, col0 = u.pn * BM + wc * 32 + 8 * fq;
        float rs[2][4]; rows_rstd(p.ssq, p.inv_dim, row0, fq, rs);
#pragma unroll
        for (int ai = 0; ai < 2; ++ai)
#pragma unroll
            for (int m = 0; m < 4; ++m) {
                const int row = row0 + ai * HALF + m * 16; const float r = rs[ai][m];
                GAS bf16_t* rowp = p.O + (size_t)row * p.ldc + col0;
#pragma unroll
                for (int bj = 0; bj < 2; ++bj) { const f32x4 v0 = acc[ai][bj][m][0] * r, v1 = acc[ai][bj][m][1] * r;
                    u32x4 w; w.x = cvtpk(v0[0], v0[1]); w.y = cvtpk(v0[2], v0[3]); w.z = cvtpk(v1[0], v1[1]); w.w = cvtpk(v1[2], v1[3]);
                    *(GAS u32x4*)(rowp + bj * HALF) = w; }
            }
    }
};
struct EpiScaleRope {
    static constexpr bool PERM = true; EpiP p;
    DI size_t hm(int row, int sec, int h) const { return ((size_t)sec * T * 16 + (size_t)(row >> 13) * (16 * S) + (size_t)h * S + (row & (S - 1))) * 64; }
    DI void operator()(const f32x4 (&acc)[2][2][4][2], const Unit& u, int wr, int wc, int fr, int fq) const {
        const int row0 = u.pm * BM + wr * 64 + fr;
        float rs[2][4]; rows_rstd(p.ssq, p.inv_dim, row0, fq, rs);
        const int sec = u.pn >> 2;
        if (u.pn >= p.rope_lo && u.pn < p.rope_hi) {
            const int h = 4 * (u.pn & 3) + wc;
            const float qs = (sec == 0) ? 0.125f * LOG2E : 1.f;
#pragma unroll
            for (int g2 = 0; g2 < 4; ++g2) {
                f32x4 cv[2][2], sv[2][2];
#pragma unroll
                for (int mm = 0; mm < 2; ++mm) { const int ai = g2 >> 1, m = (g2 & 1) * 2 + mm; const size_t tb = (size_t)(row0 + ai * HALF + m * 16) * 32 + 8 * fq;
                    cv[mm][0] = *(const GAS f32x4*)(p.rc + tb); cv[mm][1] = *(const GAS f32x4*)(p.rc + tb + 4); sv[mm][0] = *(const GAS f32x4*)(p.rs + tb); sv[mm][1] = *(const GAS f32x4*)(p.rs + tb + 4); }
                __builtin_amdgcn_sched_barrier(0);
#pragma unroll
                for (int mm = 0; mm < 2; ++mm) { const int ai = g2 >> 1, m = (g2 & 1) * 2 + mm;
                    const int row = row0 + ai * HALF + m * 16; const float r = rs[ai][m] * qs;
                    const f32x4 a0 = acc[ai][0][m][0] * r, a1 = acc[ai][0][m][1] * r, b0 = acc[ai][1][m][0] * r, b1 = acc[ai][1][m][1] * r;
                    const f32x4 l0 = a0 * cv[mm][0] - b0 * sv[mm][0], l1 = a1 * cv[mm][1] - b1 * sv[mm][1];
                    const f32x4 h0 = b0 * cv[mm][0] + a0 * sv[mm][0], h1 = b1 * cv[mm][1] + a1 * sv[mm][1];
                    GAS bf16_t* rowp = p.O + hm(row, sec, h) + 8 * fq;
                    u32x4 w; w.x = cvtpk(l0[0], l0[1]); w.y = cvtpk(l0[2], l0[3]); w.z = cvtpk(l1[0], l1[1]); w.w = cvtpk(l1[2], l1[3]); *(GAS u32x4*)rowp = w;
                    w.x = cvtpk(h0[0], h0[1]); w.y = cvtpk(h0[2], h0[3]); w.z = cvtpk(h1[0], h1[1]); w.w = cvtpk(h1[2], h1[3]); *(GAS u32x4*)(rowp + 32) = w;
                }
            }
        } else {
#pragma unroll
            for (int ai = 0; ai < 2; ++ai)
#pragma unroll
                for (int m = 0; m < 4; ++m) {
                    const int row = row0 + ai * HALF + m * 16; const float r = rs[ai][m];
#pragma unroll
                    for (int bj = 0; bj < 2; ++bj) { const f32x4 v0 = acc[ai][bj][m][0] * r, v1 = acc[ai][bj][m][1] * r;
                        u32x4 w; w.x = cvtpk(v0[0], v0[1]); w.y = cvtpk(v0[2], v0[3]); w.z = cvtpk(v1[0], v1[1]); w.w = cvtpk(v1[2], v1[3]);
                        const int h = 4 * (u.pn & 3) + 2 * bj + (wc >> 1);
                        *(GAS u32x4*)(p.O + hm(row, sec, h) + 32 * (wc & 1) + 8 * fq) = w; }
                }
        }
    }
};
DI float silu_mul(float g, float u) { return g * __builtin_amdgcn_rcpf(1.f + __builtin_amdgcn_exp2f(-g * LOG2E)) * u; }
struct EpiSwiglu {
    static constexpr bool PERM = true; EpiP p;
    DI void operator()(const f32x4 (&acc)[2][2][4][2], const Unit& u, int wr, int wc, int fr, int fq) const {
        const int row0 = u.pm * BM + wr * 64 + fr, col0 = u.pn * HALF + wc * 32 + 8 * fq;
        float rs[2][4]; rows_rstd(p.ssq, p.inv_dim, row0, fq, rs);
#pragma unroll
        for (int ai = 0; ai < 2; ++ai)
#pragma unroll
            for (int m = 0; m < 4; ++m) {
                const int row = row0 + ai * HALF + m * 16; const float r = rs[ai][m];
                const f32x4 g0 = acc[ai][0][m][0] * r, g1 = acc[ai][0][m][1] * r, u0 = acc[ai][1][m][0] * r, u1 = acc[ai][1][m][1] * r;
                u32x4 w; w.x = cvtpk(silu_mul(g0[0], u0[0]), silu_mul(g0[1], u0[1])); w.y = cvtpk(silu_mul(g0[2], u0[2]), silu_mul(g0[3], u0[3]));
                w.z = cvtpk(silu_mul(g1[0], u1[0]), silu_mul(g1[1], u1[1])); w.w = cvtpk(silu_mul(g1[2], u1[2]), silu_mul(g1[3], u1[3]));
                *(GAS u32x4*)(p.O + (size_t)row * p.ldc + col0) = w;
            }
    }
};
template <int MODE>
struct EpiResid {
    static constexpr bool PERM = true; EpiP p;
    DI void operator()(const f32x4 (&acc)[2][2][4][2], const Unit& u, int wr, int wc, int fr, int fq) const {
        typedef _Float16 f16x8 __attribute__((ext_vector_type(8)));
        const int row0 = u.pm * BM + wr * 64 + fr, col0 = u.pn * BM + wc * 32 + 8 * fq;
#pragma unroll
        for (int ai = 0; ai < 2; ++ai) {
            f32x4 xin[4][2][2];
#pragma unroll
            for (int m = 0; m < 4; ++m)
#pragma unroll
                for (int bj = 0; bj < 2; ++bj) { const size_t o2 = (size_t)(row0 + ai * HALF + m * 16) * D + col0 + bj * HALF;
                    if (MODE == 0) { xin[m][bj][0] = *(const GAS f32x4*)(p.Xin + o2); xin[m][bj][1] = *(const GAS f32x4*)(p.Xin + o2 + 4); }
                    else { const f16x8 h = *(const GAS f16x8*)(p.X16 + o2); xin[m][bj][0] = (f32x4){(float)h[0], (float)h[1], (float)h[2], (float)h[3]}; xin[m][bj][1] = (f32x4){(float)h[4], (float)h[5], (float)h[6], (float)h[7]}; } }
            __builtin_amdgcn_sched_barrier(0);
#pragma unroll
            for (int m = 0; m < 4; ++m) {
                const int row = row0 + ai * HALF + m * 16; const size_t off = (size_t)row * D + col0; float ss = 0.f;
#pragma unroll
                for (int bj = 0; bj < 2; ++bj) { const size_t o2 = off + bj * HALF;
                    const f32x4 v0 = xin[m][bj][0] + acc[ai][bj][m][0], v1 = xin[m][bj][1] + acc[ai][bj][m][1];
                    { const f16x8 h = {(_Float16)v0[0], (_Float16)v0[1], (_Float16)v0[2], (_Float16)v0[3], (_Float16)v1[0], (_Float16)v1[1], (_Float16)v1[2], (_Float16)v1[3]}; *(GAS f16x8*)(p.X16 + o2) = h; }
                    if (MODE != 2) { u32x4 w; w.x = cvtpk(v0[0], v0[1]); w.y = cvtpk(v0[2], v0[3]); w.z = cvtpk(v1[0], v1[1]); w.w = cvtpk(v1[2], v1[3]); *(GAS u32x4*)(p.XB + o2) = w; }
                    ss += ((v0[0] * v0[0] + v0[1] * v0[1]) + (v0[2] * v0[2] + v0[3] * v0[3])) + ((v1[0] * v1[0] + v1[1] * v1[1]) + (v1[2] * v1[2] + v1[3] * v1[3])); }
                ss += __shfl_xor(ss, 16); ss += __shfl_xor(ss, 32);
                if (fq == 0) p.ssq_out[(size_t)row * 16 + u.pn * 4 + wc] = ss;
            }
        }
    }
};

template <class Epi>
DI void gemm_phase(LAS unsigned char* lds, const Gemm g, const StaticOrder& S, const Epi& E, const int tid) {
    const int wid = __builtin_amdgcn_readfirstlane(tid >> 6), lane = tid & 63, wr = wid >> 2, wc = wid & 3, fr = lane & 15, fq = lane >> 4;
    const int K = g.K, nt = K / BK, lda = g.lda;
    unsigned voffA[2], voffB[2];
#pragma unroll
    for (int i = 0; i < 2; ++i) { int R, C; stage_rc(tid * 16 + i * 8192, R, C); const int Rb = Epi::PERM ? ((R & ~31) + perm32(R & 31)) : R;
        voffA[i] = (unsigned)(R * lda + C) * 2u; voffB[i] = (unsigned)(Rb * K + C) * 2u; }
    const size_t kstep = (size_t)(BK * 2);
    const size_t hstepA = (size_t)HALF * lda * 2, hstepB = (size_t)HALF * K * 2;
    const size_t tstepA = 2 * hstepA, tstepB = 2 * hstepB;
    const unsigned ldsw = (unsigned)wid * 1024u;
    const int aoff = lds_byte(wr * 64 + fr, fq * 8), boff = lds_byte(wc * 32 + fr, fq * 8);
#define PG8_SA(b, h) (((b) * 2 + (h)) * HTB)
#define PG8_SB(b, h) ((4 + (b) * 2 + (h)) * HTB)
#define PG8_STAGE(bufoff, gbase, voff) do { _Pragma("unroll") for (int _i = 0; _i < 2; ++_i) \
        __builtin_amdgcn_global_load_lds((const GAS unsigned*)((const GAS char*)(gbase) + (voff)[_i]), (LAS unsigned*)(lds + (bufoff) + ldsw + _i * 8192), 16, 0, 0); } while (0)
#define PG8_LDA(dst, b, h) do { _Pragma("unroll") for (int m = 0; m < 4; ++m) _Pragma("unroll") for (int k = 0; k < 2; ++k) dst[m][k] = *(const LAS bf16x8*)(lds + PG8_SA(b, h) + aoff + m * 2048 + k * 1024); } while (0)
#define PG8_LDB(dst, b, h) do { _Pragma("unroll") for (int n = 0; n < 2; ++n) _Pragma("unroll") for (int k = 0; k < 2; ++k) dst[n][k] = *(const LAS bf16x8*)(lds + PG8_SB(b, h) + boff + n * 2048 + k * 1024); } while (0)
#define PG8_MMA(ai, bj, At, Bt) do { __builtin_amdgcn_s_setprio(1); _Pragma("unroll") for (int m = 0; m < 4; ++m) _Pragma("unroll") for (int n = 0; n < 2; ++n) _Pragma("unroll") for (int k = 0; k < 2; ++k) \
        acc[ai][bj][m][n] = __builtin_amdgcn_mfma_f32_16x16x32_bf16(Bt[n][k], At[m][k], acc[ai][bj][m][n], 0, 0, 0); __builtin_amdgcn_s_setprio(0); } while (0)
#define PG8_WAIT_V(n) asm volatile("s_waitcnt vmcnt(" #n ")" ::: "memory")
#define PG8_WAIT_L(n) asm volatile("s_waitcnt lgkmcnt(" #n ")" ::: "memory")
#define PG8_BAR __builtin_amdgcn_s_barrier()
#define PG8_SCHED __builtin_amdgcn_sched_barrier(0)
    Unit cur, nxt; int ui = 0;
    if (!S.next(0, cur)) return;
    f32x4 acc[2][2][4][2];
#pragma unroll
    for (int a = 0; a < 2; ++a)
#pragma unroll
        for (int b = 0; b < 2; ++b)
#pragma unroll
            for (int m = 0; m < 4; ++m)
#pragma unroll
                for (int n = 0; n < 2; ++n) acc[a][b][m][n] = (f32x4){0.f, 0.f, 0.f, 0.f};
    bf16x8 At[4][2], B0[2][2], B1[2][2];
    const GAS char* cA = (const GAS char*)g.A + (size_t)cur.pm * tstepA; const GAS char* cB = (const GAS char*)g.Bt + (size_t)cur.pn * tstepB;
    PG8_STAGE(PG8_SB(0, 0), cB, voffB); PG8_STAGE(PG8_SB(0, 1), cB + hstepB, voffB); PG8_STAGE(PG8_SA(0, 0), cA, voffA); PG8_STAGE(PG8_SA(0, 1), cA + hstepA, voffA);
    if (wr == 1) PG8_BAR;
    PG8_WAIT_V(2); PG8_BAR;
    PG8_STAGE(PG8_SB(1, 0), cB + kstep, voffB); PG8_STAGE(PG8_SA(1, 0), cA + kstep, voffA); PG8_STAGE(PG8_SB(1, 1), cB + hstepB + kstep, voffB);
    PG8_WAIT_V(6); PG8_BAR;
    for (;;) {
        const bool has_next = S.next(ui + 1, nxt);
        const GAS char* nA = has_next ? (const GAS char*)g.A + (size_t)nxt.pm * tstepA : cA; const GAS char* nB = has_next ? (const GAS char*)g.Bt + (size_t)nxt.pn * tstepB : cB;
        for (int t = 0; t < nt; t += 2) {
            const bool last = (t == nt - 2);
            const GAS char* a1 = cA + (size_t)(t + 1) * kstep;
            const GAS char* a2 = last ? nA : cA + (size_t)(t + 2) * kstep; const GAS char* b2 = last ? nB : cB + (size_t)(t + 2) * kstep;
            const GAS char* a3 = a2 + kstep; const GAS char* b3 = b2 + kstep;
            PG8_LDB(B0, 0, 0); PG8_LDB(B1, 0, 1); PG8_SCHED; PG8_LDA(At, 0, 0); PG8_STAGE(PG8_SA(1, 1), a1 + hstepA, voffA);
            PG8_WAIT_V(8); PG8_WAIT_L(0); PG8_BAR; PG8_MMA(0, 0, At, B0); PG8_MMA(0, 1, At, B1); PG8_BAR; PG8_SCHED;
            PG8_LDA(At, 0, 1); PG8_STAGE(PG8_SB(0, 0), b2, voffB); PG8_STAGE(PG8_SB(0, 1), b2 + hstepB, voffB); PG8_STAGE(PG8_SA(0, 0), a2, voffA);
            PG8_WAIT_V(8); PG8_WAIT_L(0); PG8_BAR; PG8_MMA(1, 0, At, B0); PG8_MMA(1, 1, At, B1); PG8_BAR; PG8_SCHED;
            PG8_LDB(B0, 1, 0); PG8_LDB(B1, 1, 1); PG8_SCHED; PG8_LDA(At, 1, 0); PG8_STAGE(PG8_SA(0, 1), a2 + hstepA, voffA);
            PG8_WAIT_V(8); PG8_WAIT_L(0); PG8_BAR; PG8_MMA(0, 0, At, B0); PG8_MMA(0, 1, At, B1); PG8_BAR; PG8_SCHED;
            PG8_LDA(At, 1, 1); PG8_STAGE(PG8_SB(1, 0), b3, voffB); PG8_STAGE(PG8_SB(1, 1), b3 + hstepB, voffB); PG8_STAGE(PG8_SA(1, 0), a3, voffA);
            PG8_WAIT_V(8); PG8_WAIT_L(0); PG8_BAR; PG8_MMA(1, 0, At, B0); PG8_MMA(1, 1, At, B1); PG8_BAR; PG8_SCHED;
        }
        if (wr == 0) PG8_BAR;
        E(acc, cur, wr, wc, fr, fq);
        if (!has_next) break;
#pragma unroll
        for (int a = 0; a < 2; ++a)
#pragma unroll
            for (int b = 0; b < 2; ++b)
#pragma unroll
                for (int m = 0; m < 4; ++m)
#pragma unroll
                    for (int n = 0; n < 2; ++n) acc[a][b][m][n] = (f32x4){0.f, 0.f, 0.f, 0.f};
        cur = nxt; cA = nA; cB = nB; ++ui;
        if (wr == 1) PG8_BAR;
    }
    PG8_WAIT_V(0);
    PG8_BAR;
#undef PG8_SA
#undef PG8_SB
#undef PG8_STAGE
#undef PG8_LDA
#undef PG8_LDB
#undef PG8_MMA
#undef PG8_WAIT_V
#undef PG8_WAIT_L
#undef PG8_BAR
#undef PG8_SCHED
}
}

struct AttnArgs {
    const GAS bf16_t* Q; int qpitch;
    const GAS bf16_t* K1; int k1pitch;
    const GAS bf16_t* K2; int k2pitch;
    const GAS bf16_t* V; int vpitch;
    GAS bf16_t* O; int opitch;
    long qrow0, kvrow0; int dil;
    int q0, tlo, thi, W;
    float scale2, sink2;
    const GAS float* rc; const GAS float* rs;
    int omode;
    GAS float* lse_out; const GAS float* lse_a; const GAS float* lse_b; const GAS bf16_t* Oa; const GAS bf16_t* Ob; int head;
};
DI int crow(int r, int hi) { return (r & 3) + 8 * (r >> 2) + 4 * hi; }
DI void unpack8(const u32x4 r, float (&f)[8]) { f[0] = bflo(r.x); f[1] = bfhi(r.x); f[2] = bflo(r.y); f[3] = bfhi(r.y); f[4] = bflo(r.z); f[5] = bfhi(r.z); f[6] = bflo(r.w); f[7] = bfhi(r.w); }
DI bf16x8 pack8(const float (&f)[8]) { u32x4 w; w.x = cvtpk(f[0], f[1]); w.y = cvtpk(f[2], f[3]); w.z = cvtpk(f[4], f[5]); w.w = cvtpk(f[6], f[7]); return __builtin_bit_cast(bf16x8, w); }
typedef short v4i16_t __attribute__((ext_vector_type(4)));
DI s16x4 vtr(LAS const unsigned char* p) { return __builtin_bit_cast(s16x4, __builtin_amdgcn_ds_read_tr16_b64_v4i16((LAS v4i16_t*)p)); }

template <int DQK, int DV, int MASK>
DI void attn_tile(const LAS unsigned char* kb, const LAS unsigned char* vb, const bf16x8 (&qf)[DQK / 16], f32x16 (&o)[DV / 32], float& m, float& l, f32x16& negm, const bool fast,
                  const int t, const int qn, const int qw0, const int half, const int W) {
    constexpr int KSTR = DQK * 2 + 16, VSTR = DV * 2 + 64, NS = DQK / 16, ND = DV / 32;
            constexpr bool FIXREF = (DV / 32 <= 2);
            f32x16 x0, x1;
            if (FIXREF && fast) { x0 = negm; x1 = negm; }
            else {
#pragma unroll
                for (int r = 0; r < 16; ++r) { x0[r] = 0.f; x1[r] = 0.f; }
            }
            constexpr int KCH_STEPS = (NS > 6) ? 2 : NS;
            constexpr bool VPRE = (ND <= 2);
#pragma unroll
            for (int c0 = 0; c0 < NS; c0 += KCH_STEPS) {
                bf16x8 ka[KCH_STEPS], kc[KCH_STEPS];
#pragma unroll
                for (int s = 0; s < KCH_STEPS; ++s) { ka[s] = *(const LAS bf16x8*)(kb + (c0 + s) * 32); kc[s] = *(const LAS bf16x8*)(kb + 32 * KSTR + (c0 + s) * 32); }
                __builtin_amdgcn_sched_barrier(0);
#pragma unroll
                for (int s = 0; s < KCH_STEPS; ++s) {
                    x0 = __builtin_amdgcn_mfma_f32_32x32x16_bf16(ka[s], qf[c0 + s], x0, 0, 0, 0);
                    x1 = __builtin_amdgcn_mfma_f32_32x32x16_bf16(kc[s], qf[c0 + s], x1, 0, 0, 0);
                }
                __builtin_amdgcn_sched_barrier(0);
            }
            s16x4 vl[4], vh[4];
            if (VPRE) {
#pragma unroll
                for (int s = 0; s < 4; ++s) { vl[s] = vtr(vb + (16 * s) * VSTR); vh[s] = vtr(vb + (16 * s + 8) * VSTR); }
                __builtin_amdgcn_sched_barrier(0);
            }
            if (MASK != 0) {
                const bool need = (MASK == 1) ? (t * 64 + 63 > qw0) : !((t * 64 + 63 <= qw0) && (qw0 + 31 - t * 64 <= W));
                if (need) {
                    const int dbase = qn - (t * 64 + 4 * half);
#pragma unroll
                    for (int r = 0; r < 16; ++r) { const int d0 = dbase - ((r & 3) + 8 * (r >> 2)), d1 = d0 - 32;
                        const bool v0 = (MASK == 1) ? (d0 >= 0) : ((unsigned)d0 <= (unsigned)W), v1 = (MASK == 1) ? (d1 >= 0) : ((unsigned)d1 <= (unsigned)W);
                        x0[r] = v0 ? x0[r] : -INFINITY; x1[r] = v1 ? x1[r] : -INFINITY; }
                }
            }
            if (!(FIXREF && fast)) {
            float mx;
            {
#define MX3(a, b, c) __builtin_fmaxf(__builtin_fmaxf((a), (b)), (c))
                float ma = MX3(x0[0], x0[1], x1[0]), mb = MX3(x0[2], x0[3], x1[1]); ma = MX3(ma, x1[2], x1[3]);
#pragma unroll
                for (int r = 4; r < 16; r += 4) { ma = MX3(ma, x0[r], x0[r + 1]); mb = MX3(mb, x0[r + 2], x0[r + 3]); ma = MX3(ma, x1[r], x1[r + 1]); mb = MX3(mb, x1[r + 2], x1[r + 3]); }
#undef MX3
                mx = fmaxf(ma, mb);
            }
            mx = fmaxf(mx, __shfl_xor(mx, 32));
            const float mn = fmaxf(m, mx), ms = (mn == -INFINITY) ? 0.f : mn;
            if (__any(mn > m)) {
                const float alpha = __builtin_amdgcn_exp2f(m - ms);
                l *= alpha;
#pragma unroll
                for (int d = 0; d < ND; ++d)
#pragma unroll
                    for (int r = 0; r < 16; ++r) o[d][r] *= alpha;
            }
            m = mn;
            float rsum = 0.f;
#pragma unroll
            for (int r = 0; r < 16; ++r) { x0[r] = __builtin_amdgcn_exp2f(x0[r] - ms); x1[r] = __builtin_amdgcn_exp2f(x1[r] - ms); rsum += x0[r] + x1[r]; }
            l += rsum;
            if (FIXREF) {
                m = ms;
#pragma unroll
                for (int r = 0; r < 16; ++r) negm[r] = -ms;
            }
            } else {
                float rsum = 0.f;
#pragma unroll
                for (int r = 0; r < 16; ++r) { x0[r] = __builtin_amdgcn_exp2f(x0[r]); x1[r] = __builtin_amdgcn_exp2f(x1[r]); rsum += x0[r] + x1[r]; }
                l += rsum;
            }
            bf16x8 pk[4];
            { u32x4 w;
              w.x = cvtpk(x0[0], x0[1]); w.y = cvtpk(x0[2], x0[3]); w.z = cvtpk(x0[4], x0[5]); w.w = cvtpk(x0[6], x0[7]); pk[0] = __builtin_bit_cast(bf16x8, w);
              w.x = cvtpk(x0[8], x0[9]); w.y = cvtpk(x0[10], x0[11]); w.z = cvtpk(x0[12], x0[13]); w.w = cvtpk(x0[14], x0[15]); pk[1] = __builtin_bit_cast(bf16x8, w);
              w.x = cvtpk(x1[0], x1[1]); w.y = cvtpk(x1[2], x1[3]); w.z = cvtpk(x1[4], x1[5]); w.w = cvtpk(x1[6], x1[7]); pk[2] = __builtin_bit_cast(bf16x8, w);
              w.x = cvtpk(x1[8], x1[9]); w.y = cvtpk(x1[10], x1[11]); w.z = cvtpk(x1[12], x1[13]); w.w = cvtpk(x1[14], x1[15]); pk[3] = __builtin_bit_cast(bf16x8, w); }
            __builtin_amdgcn_sched_barrier(0);
            if (!VPRE) {
#pragma unroll
                for (int s = 0; s < 4; ++s) { vl[s] = vtr(vb + (16 * s) * VSTR); vh[s] = vtr(vb + (16 * s + 8) * VSTR); }
                __builtin_amdgcn_sched_barrier(0);
            }
#pragma unroll
            for (int d = 0; d < ND; ++d) {
                s16x4 nl[4], nh[4];
                if (d + 1 < ND) {
#pragma unroll
                    for (int s = 0; s < 4; ++s) { nl[s] = vtr(vb + (16 * s) * VSTR + (d + 1) * 64); nh[s] = vtr(vb + (16 * s + 8) * VSTR + (d + 1) * 64); }
                    __builtin_amdgcn_sched_barrier(0);
                }
#pragma unroll
                for (int s = 0; s < 4; ++s) {
                    const bf16x8 vf = (bf16x8){vl[s][0], vl[s][1], vl[s][2], vl[s][3], vh[s][0], vh[s][1], vh[s][2], vh[s][3]};
                    o[d] = __builtin_amdgcn_mfma_f32_32x32x16_bf16(vf, pk[s], o[d], 0, 0, 0);
                }
                if (d + 1 < ND) {
#pragma unroll
                    for (int s = 0; s < 4; ++s) { vl[s] = nl[s]; vh[s] = nh[s]; }
                }
                __builtin_amdgcn_sched_barrier(0);
            }

}

template <int DQK, int DV, int KC1, int MASK, int ROPE, bool ALLT = false, int TR = 64>
DI void attn_unit(LAS unsigned char* lds, const AttnArgs& a, const int tid_in, u32x4 (&sk)[6], u32x4 (&sv)[6], const bool pre, const bool has_next, const AttnArgs& an) {
    int tid = tid_in; asm volatile("" : "+v"(tid));
    constexpr int KSTR = DQK * 2 + 16, VSTR = DV * 2 + 64;
    constexpr int KB = TR * KSTR, VB = TR * VSTR, BUF = KB + VB;
    constexpr int KCPR = DQK / 8, VCPR = DV / 8, KCH = TR * KCPR, VCH = TR * VCPR, NCH = KCH + VCH, NI = (NCH + 511) / 512;
    constexpr int NS = DQK / 16, ND = DV / 32;
    const int lane = tid & 63, wave = __builtin_amdgcn_readfirstlane(tid >> 6), l31 = lane & 31, half = lane >> 5;

    constexpr bool UNI = (KC1 == KCPR);
    const int gsu = 2 * TR * a.dil * a.k1pitch;
    const GAS char* gp[NI]; unsigned lo[NI]; int gst[UNI ? 1 : NI];
#define GST(i) (UNI ? gsu : gst[UNI ? 0 : (i)])
#pragma unroll
    for (int i = 0; i < NI; ++i) {
        int cid = tid + 512 * i; gp[i] = (const GAS char*)(a.K1 + (a.kvrow0 + (long)(a.tlo * 64) * a.dil) * a.k1pitch); lo[i] = 2 * BUF + (tid & 255) * 16; if (!UNI) gst[i] = 0;
        if (cid < KCH) { const int row = cid / KCPR, c = cid % KCPR; const long grow = a.kvrow0 + (long)(a.tlo * 64 + row) * a.dil;
            if (c < KC1) { gp[i] = (const GAS char*)(a.K1 + grow * a.k1pitch + c * 8); if (!UNI) gst[i] = 2 * TR * a.dil * a.k1pitch; }
            else { gp[i] = (const GAS char*)(a.K2 + grow * a.k2pitch + (c - KC1) * 8); if (!UNI) gst[i] = 2 * TR * a.dil * a.k2pitch; }
            lo[i] = row * KSTR + c * 16; }
        else if (cid < NCH) { cid -= KCH; const int row = cid / VCPR, c = cid % VCPR; const long grow = a.kvrow0 + (long)(a.tlo * 64 + row) * a.dil;
            gp[i] = (const GAS char*)(a.V + grow * a.vpitch + c * 8); if (!UNI) gst[i] = 2 * TR * a.dil * a.vpitch; lo[i] = KB + row * VSTR + c * 16; }
    }
    u32x4 sA[NI], sB[NI];
    constexpr int NTMAX = 6;
    const int ntile = a.thi - a.tlo;
    if (ALLT) {
        if (!pre) {
            const int row = tid >> 3, c = tid & 7; const long grow = a.kvrow0 + (long)(a.tlo * 64 + row) * a.dil;
            const GAS char* kp0 = (const GAS char*)(a.K1 + grow * a.k1pitch + c * 8); const GAS char* vp0 = (const GAS char*)(a.V + grow * a.vpitch + c * 8);
#pragma unroll
            for (int tt = 0; tt < NTMAX; ++tt) { const int ts = tt < ntile ? tt : ntile - 1; sk[tt] = *(const GAS u32x4*)(kp0 + ts * gsu); sv[tt] = *(const GAS u32x4*)(vp0 + ts * gsu); }
        }
    } else {
#pragma unroll
        for (int i = 0; i < NI; ++i) sA[i] = *(const GAS u32x4*)(gp[i]);
        if (TR == 64 && NI <= 3 && a.tlo + 1 < a.thi) {
#pragma unroll
            for (int i = 0; i < NI; ++i) sB[i] = *(const GAS u32x4*)(gp[i] + GST(i));
        }
    }
    const int qn = a.q0 + wave * 32 + l31; const long qrow = a.qrow0 + (long)qn * a.dil;
    bf16x8 qf[NS];
    {
        const GAS bf16_t* qp = a.Q + qrow * a.qpitch + 8 * half;
        float f[NS][8];
#pragma unroll
        for (int s = 0; s < NS; ++s) unpack8(*(const GAS u32x4*)(qp + 16 * s), f[s]);
        if (ROPE == 1 && a.rc != nullptr) {
#pragma unroll
            for (int s = 0; s < 2; ++s) {
                const GAS f32x4* cp = (const GAS f32x4*)(a.rc + qrow * 32 + 16 * s + 8 * half); const GAS f32x4* sp = (const GAS f32x4*)(a.rs + qrow * 32 + 16 * s + 8 * half);
                const f32x4 c0 = cp[0], c1 = cp[1], s0 = sp[0], s1 = sp[1];
#pragma unroll
                for (int j = 0; j < 8; ++j) { const float c = j < 4 ? c0[j & 3] : c1[j & 3], sn = j < 4 ? s0[j & 3] : s1[j & 3];
                    const float x1 = f[s][j], x2 = f[s + 2][j]; f[s][j] = x1 * c - x2 * sn; f[s + 2][j] = x2 * c + x1 * sn; }
            }
        } else if (ROPE == 2) {
            const GAS f32x4* cp = (const GAS f32x4*)(a.rc + qrow * 16 + 8 * half); const GAS f32x4* sp = (const GAS f32x4*)(a.rs + qrow * 16 + 8 * half);
            const f32x4 c0 = cp[0], c1 = cp[1], s0 = sp[0], s1 = sp[1];
#pragma unroll
            for (int j = 0; j < 8; ++j) { const float c = j < 4 ? c0[j & 3] : c1[j & 3], sn = j < 4 ? s0[j & 3] : s1[j & 3];
                const float x1 = f[NS - 2][j], x2 = f[NS - 1][j]; f[NS - 2][j] = x1 * c - x2 * sn; f[NS - 1][j] = x2 * c + x1 * sn; }
        }
#pragma unroll
        for (int s = 0; s < NS; ++s) {
#pragma unroll
            for (int j = 0; j < 8; ++j) f[s][j] *= a.scale2;
            qf[s] = pack8(f[s]);
        }
    }
    float m = a.sink2, l = (a.sink2 > -1e30f && half == 0) ? 1.f : 0.f;
    f32x16 negm;
#pragma unroll
    for (int r = 0; r < 16; ++r) negm[r] = 0.f;
    f32x16 o[ND];
#pragma unroll
    for (int d = 0; d < ND; ++d)
#pragma unroll
        for (int r = 0; r < 16; ++r) o[d][r] = 0.f;

    const int qw0 = a.q0 + wave * 32;
    int wlo = a.tlo, whi = a.thi;
    if (MASK >= 1) { const int e = (qw0 + 31) / 64 + 1; whi = e < whi ? e : whi; }
    if (MASK == 2) { const int s0 = qw0 - a.W; const int b = s0 > 0 ? s0 / 64 : 0; wlo = b > wlo ? b : wlo; }

    const LAS unsigned char* kfrag = lds + l31 * KSTR + half * 16;
    const LAS unsigned char* vfrag = lds + KB + (4 * half + ((lane & 15) >> 2)) * VSTR + ((lane >> 4) & 1) * 32 + (lane & 3) * 8;

    if constexpr (TR == 128) {
        __syncthreads();
#pragma unroll
        for (int i = 0; i < NI; ++i) *(LAS u32x4*)(lds + lo[i]) = sA[i];
        __syncthreads();
        for (int t = a.tlo; t < a.thi; t += 2) {
            const int cur = ((t - a.tlo) >> 1) & 1;
            if (t + 2 < a.thi) {
#pragma unroll
                for (int i = 0; i < NI; ++i) sA[i] = *(const GAS u32x4*)(gp[i] + ((t + 2 - a.tlo) >> 1) * GST(i));
            }
            if (t >= wlo && t < whi) attn_tile<DQK, DV, MASK>(kfrag + cur * BUF, vfrag + cur * BUF, qf, o, m, l, negm, t != wlo, t, qn, qw0, half, a.W);
            if (t + 1 >= wlo && t + 1 < whi) attn_tile<DQK, DV, MASK>(kfrag + cur * BUF + 64 * KSTR, vfrag + cur * BUF + 64 * VSTR, qf, o, m, l, negm, t + 1 != wlo, t + 1, qn, qw0, half, a.W);
            if (t + 2 < a.thi) {
#pragma unroll
                for (int i = 0; i < NI; ++i) *(LAS u32x4*)(lds + ((tid + 512 * i < NCH) ? (cur ^ 1) * BUF : 0) + lo[i]) = sA[i];
            }
            __syncthreads();
        }
    } else
    if (!ALLT) {
    if (NI > 3 && a.tlo + 1 < a.thi) {
#pragma unroll
        for (int i = 0; i < NI; ++i) sB[i] = *(const GAS u32x4*)(gp[i] + GST(i));
    }
    __syncthreads();
#pragma unroll
    for (int i = 0; i < NI; ++i) *(LAS u32x4*)(lds + lo[i]) = sA[i];
    __syncthreads();
#define ATT_ITER(PEND, NEW) { \
        const int cur = (t - a.tlo) & 1; \
        if (t + 2 < a.thi) { _Pragma("unroll") for (int i = 0; i < NI; ++i) NEW[i] = *(const GAS u32x4*)(gp[i] + (t + 2 - a.tlo) * GST(i)); } \
        if (t >= wlo && t < whi) attn_tile<DQK, DV, MASK>(kfrag + cur * BUF, vfrag + cur * BUF, qf, o, m, l, negm, t != wlo, t, qn, qw0, half, a.W); \
        if (t + 1 < a.thi) { _Pragma("unroll") for (int i = 0; i < NI; ++i) *(LAS u32x4*)(lds + ((tid + 512 * i < NCH) ? (cur ^ 1) * BUF : 0) + lo[i]) = PEND[i]; } \
        __syncthreads(); }
    for (int t = a.tlo;;) {
        ATT_ITER(sB, sA)
        if (++t >= a.thi) break;
        ATT_ITER(sA, sB)
        if (++t >= a.thi) break;
    }
#undef ATT_ITER
#undef GST
    } else {
        __syncthreads();
        { const int row = tid >> 3, c = tid & 7;
#pragma unroll
          for (int tt = 0; tt < (ALLT ? NTMAX : 1); ++tt) { *(LAS u32x4*)(lds + tt * BUF + row * KSTR + c * 16) = sk[tt]; *(LAS u32x4*)(lds + tt * BUF + KB + row * VSTR + c * 16) = sv[tt]; } }
        __syncthreads();
        if (has_next) {
            const int row = tid >> 3, c = tid & 7; const long grow = an.kvrow0 + (long)(an.tlo * 64 + row) * an.dil; const int nnt = an.thi - an.tlo, ngs = 128 * an.dil * an.k1pitch;
            const GAS char* kp0 = (const GAS char*)(an.K1 + grow * an.k1pitch + c * 8); const GAS char* vp0 = (const GAS char*)(an.V + grow * an.vpitch + c * 8);
#pragma unroll
            for (int tt = 0; tt < (ALLT ? NTMAX : 1); ++tt) { const int ts = tt < nnt ? tt : nnt - 1; sk[tt] = *(const GAS u32x4*)(kp0 + ts * ngs); sv[tt] = *(const GAS u32x4*)(vp0 + ts * ngs); }
        }
        for (int t = wlo; t < whi; ++t) attn_tile<DQK, DV, MASK>(kfrag + (t - a.tlo) * BUF, vfrag + (t - a.tlo) * BUF, qf, o, m, l, negm, t != wlo, t, qn, qw0, half, a.W);
        __syncthreads();
    }

    const float lt = l + __shfl_xor(l, 32);
    float wself = __builtin_amdgcn_rcpf(lt), wa = 0.f, wb = 0.f;
    if (a.omode == 1) { if (half == 0) a.lse_out[qrow * 16 + a.head] = m + __builtin_amdgcn_logf(lt); }
    if (a.omode == 2) {
        const float L3 = m + __builtin_amdgcn_logf(lt), La = a.lse_a[qrow * 16 + a.head], Lb = a.lse_b[qrow * 16 + a.head];
        const float M = fmaxf(L3, fmaxf(La, Lb));
        const float ea = __builtin_amdgcn_exp2f(La - M), eb = __builtin_amdgcn_exp2f(Lb - M), e3 = __builtin_amdgcn_exp2f(L3 - M);
        const float inv = __builtin_amdgcn_rcpf(ea + eb + e3);
        wa = ea * inv; wb = eb * inv; wself = e3 * inv * wself;
    }
    constexpr int OSTR = DV * 2 + 16, OST0 = ALLT ? 0 : 2 * BUF + 4096;
    LAS unsigned char* stg = lds + OST0 + wave * (32 * OSTR);
#pragma unroll
    for (int d = 0; d < ND; ++d)
#pragma unroll
        for (int g = 0; g < 4; ++g) {
            float v0 = o[d][4 * g] * wself, v1 = o[d][4 * g + 1] * wself, v2 = o[d][4 * g + 2] * wself, v3 = o[d][4 * g + 3] * wself;
            const int col = 32 * d + 8 * g;
            if (a.omode == 2) {
                const u32x2 pa = *(const GAS u32x2*)(a.Oa + qrow * a.opitch + 4 * half + col), pb = *(const GAS u32x2*)(a.Ob + qrow * a.opitch + 4 * half + col);
                v0 += wa * bflo(pa.x) + wb * bflo(pb.x); v1 += wa * bfhi(pa.x) + wb * bfhi(pb.x);
                v2 += wa * bflo(pa.y) + wb * bflo(pb.y); v3 += wa * bfhi(pa.y) + wb * bfhi(pb.y);
            }
            u32x2 w; w.x = cvtpk(v0, v1); w.y = cvtpk(v2, v3);
            *(LAS u32x2*)(stg + l31 * OSTR + (col + 4 * half) * 2) = w;
        }
    asm volatile("s_waitcnt lgkmcnt(0)" ::: "memory");
    {
        constexpr int CPR = DV / 8, RPI = 64 / CPR;
        const int rr = lane / CPR, ch = lane % CPR;
#pragma unroll
        for (int i = 0; i < 32 / RPI; ++i) {
            const int row = i * RPI + rr;
            const u32x4 v = *(const LAS u32x4*)(stg + row * OSTR + ch * 16);
            const long grow = a.qrow0 + (long)(a.q0 + wave * 32 + row) * a.dil;
            *(GAS u32x4*)(a.O + grow * a.opitch + ch * 8) = v;
        }
    }
}

DI AttnArgs band_args(int u, int layer, int dil, GAS bf16_t* BIG, GAS bf16_t* R1, GAS bf16_t* R2, GAS float* LSE1, GAS float* LSE2, const GAS float* R64C, const GAS float* R64S, const GAS float* sinks) {
    AttnArgs a{};
    a.rc = R64C; a.rs = R64S; a.scale2 = 0.125f * LOG2E;
    if (layer == 0) {
        const int qb = u & 31, h = (u >> 5) & 7, b = u >> 8, kvh = h >> 2;
        a.Q = BIG + h * 64; a.qpitch = ZP; a.K1 = BIG + Z_KA + kvh * 64; a.k1pitch = ZP; a.K2 = a.K1; a.k2pitch = ZP; a.V = BIG + Z_VA + kvh * 64; a.vpitch = ZP;
        a.O = R2 + h * 64; a.opitch = D; a.qrow0 = (long)b * S; a.kvrow0 = a.qrow0; a.dil = 1; a.q0 = qb * 256; a.W = 127;
        a.tlo = qb * 4 - 2 < 0 ? 0 : qb * 4 - 2; a.thi = qb * 4 + 4;
        a.sink2 = sinks[h] * LOG2E; a.omode = 0; a.head = h;
    } else {
        const int nblk = 32 / dil; const int nb = u % nblk, r = (u / nblk) % dil, h = (u >> 5) & 15, b = u >> 9;
        const size_t slab = ((size_t)b * 15 * S + (size_t)h * S) * 64;
        a.Q = BIG + slab; a.qpitch = 64; a.K1 = BIG + (size_t)T * 1024 + slab; a.k1pitch = 64; a.K2 = a.K1; a.k2pitch = 64; a.V = BIG + (size_t)T * 2048 + slab; a.vpitch = 64;
        a.opitch = D; a.qrow0 = (long)b * S + r; a.kvrow0 = a.qrow0; a.dil = dil; a.q0 = nb * 256; a.W = 128;
        a.tlo = nb * 4 - 2 < 0 ? 0 : nb * 4 - 2; a.thi = nb * 4 + 4;
        a.sink2 = -INFINITY; a.head = h; a.rc = nullptr; a.rs = nullptr; a.scale2 = 1.f;
        if (dil == 1) { a.omode = 1; a.O = R1 + h * 64; a.lse_out = LSE1; }
        else if (dil == 4) { a.omode = 1; a.O = R2 + h * 64; a.lse_out = LSE2; }
        else { a.omode = 2; a.O = R1 + h * 64; a.Oa = R1 + h * 64; a.Ob = R2 + h * 64; a.lse_a = LSE1; a.lse_b = LSE2; }
    }
    return a;
}

DI void wt_item(const GAS float* W, int ldw, int K, const GAS float* g, GAS bf16_t* Bt, int roff, int rbs, int ncols, int nblk, int item, LAS float* scr, int lane, int rp_lo = 0, int rp_hi = 0) {
    const int kb = item / nblk, nb = item % nblk, k0 = 64 * kb, c0 = 32 * nb;
    const int c = c0 + (lane & 31);
    float wv[32];
    const int cl = c < ncols ? c : ncols - 1;
#pragma unroll
    for (int i = 0; i < 32; ++i) wv[i] = W[(size_t)(k0 + 2 * i + (lane >> 5)) * ldw + cl];
    const float gsel = (c < ncols) ? 1.f : 0.f;
#pragma unroll
    for (int i = 0; i < 32; ++i) { const int kk = 2 * i + (lane >> 5); float v = wv[i] * gsel; if (g) v *= g[k0 + kk]; scr[kk * 33 + (lane & 31)] = v; }
    asm volatile("s_waitcnt lgkmcnt(0)" ::: "memory");
    const int cch = lane & 7;
#pragma unroll
    for (int j = 0; j < 4; ++j) { const int n = (lane >> 3) + 8 * j; const LAS float* s = scr + (8 * cch) * 33 + n;
        u32x4 o; o.x = cvtpk(s[0 * 33], s[1 * 33]); o.y = cvtpk(s[2 * 33], s[3 * 33]); o.z = cvtpk(s[4 * 33], s[5 * 33]); o.w = cvtpk(s[6 * 33], s[7 * 33]);
        const int cc = c0 + n; int drow = roff + (cc >> 7) * rbs + (cc & 127);
        if (cc >= rp_lo && cc < rp_hi) drow = roff + (cc & ~255) + 128 * ((cc >> 5) & 1) + 32 * ((cc >> 6) & 3) + (cc & 31);
        *(GAS u32x4*)(Bt + (size_t)drow * K + k0 + 8 * cch) = o; }
    asm volatile("s_waitcnt lgkmcnt(0)" ::: "memory");
}
DI void row_to_bf16(const GAS float* xrow, GAS bf16_t* orow, GAS float* ssq16, int lane) {
    const GAS f32x4* xr = (const GAS f32x4*)xrow + lane; f32x4 v[4]; float s = 0.f;
#pragma unroll
    for (int j = 0; j < 4; ++j) { v[j] = xr[64 * j]; s += (v[j][0] * v[j][0] + v[j][1] * v[j][1]) + (v[j][2] * v[j][2] + v[j][3] * v[j][3]); }
    s = wave_sum(s);
    GAS u32x2* o8 = (GAS u32x2*)orow + lane;
#pragma unroll
    for (int j = 0; j < 4; ++j) { u32x2 w; w.x = cvtpk(v[j][0], v[j][1]); w.y = cvtpk(v[j][2], v[j][3]); o8[64 * j] = w; }
    if (lane < 16) ssq16[lane] = lane == 0 ? s : 0.f;
}


#define XB_TMO      128
#define XB_XCNT(j)  (256  + 64 * (j))
#define XB_XSUB(j)  (1280 + 64 * (j))
#define XB_XGEN(j)  (2304 + 64 * (j))
#define XB_TOP      3328
#define XB_TOPGEN   3392
#define XCD_BAR_WORDS 3456
#define XB_SPIN_CAP (1u << 22)
DI unsigned xb_ld(unsigned* p)              { return __hip_atomic_load(p, __ATOMIC_RELAXED, __HIP_MEMORY_SCOPE_AGENT); }
DI unsigned xb_add(unsigned* p, unsigned v) { return __hip_atomic_fetch_add(p, v, __ATOMIC_RELAXED, __HIP_MEMORY_SCOPE_AGENT); }
DI unsigned xb_xcc_id() { return (unsigned)__builtin_amdgcn_s_getreg((3 << 11) | 20) & 0xFu; }
#define XB_SPIN(cond, bar) do { unsigned _sp = 0; while (cond) { __builtin_amdgcn_s_sleep(1); \
    if ((++_sp & 255u) == 0u) { if (xb_ld(&(bar)[XB_TMO])) break; if (_sp > XB_SPIN_CAP) { atomicAdd(&(bar)[XB_TMO], 1u); break; } } } } while (0)
struct XcdBarrier { unsigned* bar; unsigned x; volatile LAS unsigned* st; };
DI XcdBarrier xcd_barrier_post(unsigned* bar, volatile LAS unsigned* st) {
    XcdBarrier b; b.bar = bar; b.x = xb_xcc_id(); b.st = st;
    if (threadIdx.x == 0) (void)xb_add(&bar[XB_XCNT(b.x)], 1u);
    return b;
}
DI void xcd_barrier_complete(unsigned* bar, unsigned x, unsigned& nloc, unsigned& nx) {
    const unsigned G = gridDim.x * gridDim.y * gridDim.z;
    unsigned sum, cnt, mine, sp = 0u;
    for (;;) {
        sum = 0u; cnt = 0u; mine = 0u;
#pragma unroll
        for (unsigned j = 0; j < 16; ++j) { const unsigned c = xb_ld(&bar[XB_XCNT(j)]); sum += c; cnt += (c > 0u) ? 1u : 0u; mine = (j == x) ? c : mine; }
        if (sum == G) break;
        __builtin_amdgcn_s_sleep(1);
        if ((++sp & 255u) == 0u) { if (xb_ld(&bar[XB_TMO])) break; if (sp > XB_SPIN_CAP) { atomicAdd(&bar[XB_TMO], 1u); break; } }
    }
    nloc = mine > 0u ? mine : 1u; nx = cnt > 0u ? cnt : 1u;
}
DI void xcd_barrier(const XcdBarrier& b) {
    asm volatile("s_waitcnt vmcnt(0)" ::: "memory");
    __syncthreads();
    if (threadIdx.x == 0) {
        unsigned* bar = b.bar;
        __builtin_amdgcn_s_waitcnt(0);
        unsigned nloc = b.st[0], nx = b.st[1];
        if (nloc == 0u) { xcd_barrier_complete(bar, b.x, nloc, nx); b.st[0] = nloc; b.st[1] = nx; }
        const unsigned old = xb_add(&bar[XB_XSUB(b.x)], 1u);
        const unsigned gen = old / nloc;
        if (old + 1u == (gen + 1u) * nloc) {
            __builtin_amdgcn_fence(__ATOMIC_RELEASE, "agent");
            asm volatile("s_waitcnt vmcnt(0)" ::: "memory");
            const unsigned og = xb_add(&bar[XB_TOP], 1u);
            const unsigned tg = og / nx;
            if (og + 1u == (tg + 1u) * nx) xb_add(&bar[XB_TOPGEN], 1u);
            else XB_SPIN(xb_ld(&bar[XB_TOPGEN]) == tg, bar);
            __builtin_amdgcn_fence(__ATOMIC_ACQUIRE, "agent");
            xb_add(&bar[XB_XGEN(b.x)], 1u);
            asm volatile("s_waitcnt vmcnt(0)" ::: "memory");
        } else {
            XB_SPIN(xb_ld(&bar[XB_XGEN(b.x)]) == gen, bar);
            __builtin_amdgcn_fence(__ATOMIC_ACQUIRE, "agent");
            asm volatile("s_waitcnt vmcnt(0)" ::: "memory");
        }
    }
    __syncthreads();
}

#ifndef REPEAT_MASK
#define REPEAT_MASK 0u
#endif
struct Params { const void* in[33]; float* out; unsigned char* ws; int lo, hi; };

__global__ void __launch_bounds__(512, 2) fwd_kernel(Params P) {
    extern __shared__ __attribute__((aligned(16))) unsigned char lds_raw[];
    LAS unsigned char* lds = (LAS unsigned char*)lds_raw;
    cg::grid_group grid = cg::this_grid();
    const int wave0 = __builtin_amdgcn_readfirstlane(threadIdx.x >> 6);
    volatile LAS unsigned* bst = (volatile LAS unsigned*)(lds + 163840 - 64);
    if (threadIdx.x < 2) bst[threadIdx.x] = 0u;
    unsigned* barw = (unsigned*)P.ws;
    __syncthreads();
    if (P.hi < 0) grid.sync();
    XcdBarrier xbar = xcd_barrier_post(barw, bst);
    for (int st2 = 2 * P.lo; st2 < 2 * P.hi; ++st2) {
        const int st = st2 >> 1;
        if ((st2 & 1) && !((REPEAT_MASK >> st) & 1u)) continue;
        int zero; asm volatile("s_mov_b32 %0, 0" : "=s"(zero));
        int tid = wave0 * 64 + (int)__builtin_amdgcn_mbcnt_hi(~0u, __builtin_amdgcn_mbcnt_lo(~0u, 0u)); asm volatile("" : "+v"(tid));
        const int lane = tid & 63, wave = __builtin_amdgcn_readfirstlane(tid >> 6);
        GAS unsigned char* ws = (GAS unsigned char*)P.ws; asm volatile("" : "+s"(ws));
        int G = gridDim.x, bid = blockIdx.x; asm volatile("" : "+s"(G), "+s"(bid));
        const int gw = bid * 8 + wave, NGW = G * 8;
        const int vcu = (G == 256) ? (bid & 7) * 32 + (bid >> 3) : bid;
#define WSB(off) ((GAS bf16_t*)(ws + (off) * MiB))
#define WSF(off) ((GAS float*)(ws + (off) * MiB))
#define PIN(k) (P.in[(k) + zero])
        const GAS float* x_in = (const GAS float*)PIN(0); const GAS float* mem_in = (const GAS float*)PIN(1); const GAS int* pos_in = (const GAS int*)PIN(2);
        GAS float* X = (GAS float*)P.out; asm volatile("" : "+s"(X));
        GAS bf16_t* XB = WSB(O_XB); GAS bf16_t* BIG = WSB(O_BIG); GAS bf16_t* R1 = WSB(O_R1); GAS bf16_t* R2 = WSB(O_R2); GAS bf16_t* OB = WSB(O_OB);
        GAS bf16_t* QB = BIG + (size_t)T * ZP;
        GAS bf16_t* QX = R2; GAS bf16_t* OX = R2 + (size_t)T * 512;
        GAS bf16_t* MEMB = WSB(O_MEMB); GAS bf16_t* MEMKV = WSB(O_MEMKV);
        GAS float* SSQ = WSF(O_SSQ); GAS float* SSQQ = WSF(O_SSQQ); GAS float* SSQKV = WSF(O_SSQKV); GAS float* MEMSSQ = WSF(O_MEMSSQ);
        GAS float* R64C = WSF(O_R64C); GAS float* R64S = WSF(O_R64S); GAS float* R32C = WSF(O_R32C); GAS float* R32S = WSF(O_R32S);
        GAS float* LSE1 = WSF(O_LSE1); GAS float* LSE2 = WSF(O_LSE2);
        int kind = 0;
        bool sync_after = true;
        pg8::Gemm g{nullptr, nullptr, 0, 0, 0, 0}; pg8::EpiP e{nullptr, 0, nullptr, 0.f, nullptr, nullptr, nullptr, nullptr, nullptr, nullptr, nullptr, 0, 0};
        e.X16 = (GAS _Float16*)WSB(O_OB); int rmode = 1;
        int layer = 0, dil = 1;
        switch (st) {
        case 1: kind = 1; g = {XB, WSB(W_IN), T, ZP, D, D}; e.O = BIG; e.ldc = ZP; e.ssq = SSQ; e.inv_dim = 1.f / D; sync_after = false; break;
        case 2: kind = 1; g = {MEMB, WSB(W_XKV), MROWS, 2048, D, D}; e.O = MEMKV; e.ldc = 2048; e.ssq = MEMSSQ; e.inv_dim = 1.f / D; break;
        case 4: kind = 1; g = {BIG + Z_CQ, WSB(W_UQ), T, 768, 384, ZP}; e.O = QB; e.ldc = 768; e.ssq = SSQQ; e.inv_dim = 1.f / 384; sync_after = false; break;
        case 5: kind = 1; g = {BIG + Z_CKV, WSB(W_UKV), T, 1024, 256, ZP}; e.O = R1; e.ldc = 1024; e.ssq = SSQKV; e.inv_dim = 1.f / 256; sync_after = false; break;
        case 6: kind = 4; layer = 0; break;
        case 7: kind = 5; break;
        case 8: kind = 3; rmode = 0; g = {R2, WSB(W_OUT0), T, D, D, D}; e.Xin = x_in; e.Xout = X; e.XB = XB; e.ssq_out = SSQ; break;
        case 9: kind = 1; g = {XB, WSB(W_XQ0), T, 512, D, D}; e.O = QX; e.ldc = 512; e.ssq = SSQ; e.inv_dim = 1.f / D; break;
        case 10: kind = 6; layer = 0; break;
        case 11: kind = 3; g = {OX, WSB(W_XO0), T, D, 512, 512}; e.Xin = X; e.Xout = X; e.XB = XB; e.ssq_out = SSQ; break;
        case 12: kind = 2; g = {XB, WSB(W_GU0), T, 2 * FF, D, D}; e.O = BIG; e.ldc = FF; e.ssq = SSQ; e.inv_dim = 1.f / D; break;
        case 13: kind = 3; g = {BIG, WSB(W_DN0), T, D, FF, FF}; e.Xin = X; e.Xout = X; e.XB = XB; e.ssq_out = SSQ; break;
        case 14: kind = 7; g = {XB, WSB(W_QKV), T, 3072, D, D}; e.O = BIG; e.ldc = 3072; e.ssq = SSQ; e.inv_dim = 1.f / D; e.rc = R64C; e.rs = R64S; e.rope_lo = 0; e.rope_hi = 8; break;
        case 15: sync_after = false; break;
        case 16: kind = 4; layer = 1; dil = 1; sync_after = false; break;
        case 17: kind = 4; layer = 1; dil = 4; break;
        case 18: kind = 4; layer = 1; dil = 16; break;
        case 19: kind = 3; g = {R1, WSB(W_OUT1), T, D, D, D}; e.Xin = X; e.Xout = X; e.XB = XB; e.ssq_out = SSQ; break;
        case 20: kind = 1; g = {XB, WSB(W_XQ1), T, 512, D, D}; e.O = QX; e.ldc = 512; e.ssq = SSQ; e.inv_dim = 1.f / D; break;
        case 21: kind = 6; layer = 1; break;
        case 22: kind = 3; g = {OX, WSB(W_XO1), T, D, 512, 512}; e.Xin = X; e.Xout = X; e.XB = XB; e.ssq_out = SSQ; break;
        case 23: kind = 2; g = {XB, WSB(W_GU1), T, 2 * FF, D, D}; e.O = BIG; e.ldc = FF; e.ssq = SSQ; e.inv_dim = 1.f / D; break;
        case 24: kind = 3; rmode = 2; g = {BIG, WSB(W_DN1), T, D, FF, FF}; e.Xin = X; e.Xout = X; e.XB = XB; e.ssq_out = SSQ; break;
        default: break;
        }
        if ((kind >= 1 && kind <= 3) || kind == 7) {
            pg8::StaticOrder SO; SO.init(g.M, g.N, G, bid);
            if (kind == 7) { pg8::EpiScaleRope E{e}; pg8::gemm_phase(lds, g, SO, E, tid); }
            else if (kind == 1) { pg8::EpiScale E{e}; pg8::gemm_phase(lds, g, SO, E, tid); }
            else if (kind == 2) { pg8::EpiSwiglu E{e}; pg8::gemm_phase(lds, g, SO, E, tid); }
            else if (rmode == 0) { pg8::EpiResid<0> E{e}; pg8::gemm_phase(lds, g, SO, E, tid); }
            else if (rmode == 1) { pg8::EpiResid<1> E{e}; pg8::gemm_phase(lds, g, SO, E, tid); }
            else { pg8::EpiResid<2> E{e}; pg8::gemm_phase(lds, g, SO, E, tid); }
        } else if (kind == 4) {
            const int nunits = layer == 0 ? 2048 : 4096;
            u32x4 sk[6], sv[6]; bool pre = false;
#pragma unroll
            for (int i = 0; i < 6; ++i) { sk[i] = (u32x4){0u, 0u, 0u, 0u}; sv[i] = (u32x4){0u, 0u, 0u, 0u}; }
            for (int u = vcu; u < nunits; u += G) {
                const bool hn = (u + G < nunits);
                const AttnArgs a = band_args(u, layer, dil, BIG, R1, R2, LSE1, LSE2, R64C, R64S, (const GAS float*)PIN(5));
                const AttnArgs an = band_args(hn ? u + G : u, layer, dil, BIG, R1, R2, LSE1, LSE2, R64C, R64S, (const GAS float*)PIN(5));
                attn_unit<64, 64, 8, 2, 1, true>(lds, a, tid, sk, sv, pre, hn, an);
                pre = hn;
            }
        } else if (kind == 5) {
            for (int rr = 0; rr < 8; ++rr) {
                int qb, bh;
                if (G == 256) { const int xcd = bid & 7, j = bid >> 3; bh = xcd * 8 + rr; qb = (rr & 1) ? 31 - j : j; }
                else { const int i = rr * G + ((rr & 1) ? (G - 1 - bid) : bid); if (i >= 2048) break; qb = 31 - (i >> 6); bh = i & 63; }
                const int b = bh >> 3, h = bh & 7;
                AttnArgs a{};
                a.rc = R32C; a.rs = R32S; a.scale2 = 0.10206207261596577f * LOG2E;
                a.Q = QB + h * 96; a.qpitch = 768; a.K1 = R1 + h * 128; a.k1pitch = 1024; a.K2 = BIG + Z_KR; a.k2pitch = ZP; a.V = R1 + h * 128 + 64; a.vpitch = 1024;
                a.O = R2 + 512 + h * 64; a.opitch = D; a.qrow0 = (long)b * S; a.kvrow0 = a.qrow0; a.dil = 1; a.q0 = qb * 256; a.W = 0;
                a.tlo = 0; a.thi = qb * 4 + 4; a.sink2 = -INFINITY; a.omode = 0; a.head = h;
                { u32x4 dk[6] = {}, dv[6] = {}; attn_unit<96, 64, 8, 1, 2, false, 128>(lds, a, tid, dk, dv, false, false, a); }
            }
        } else if (kind == 6) {
            for (int u = vcu; u < 1024; u += G) {
                const int qb = u & 31, h = (u >> 5) & 3, b = u >> 7;
                AttnArgs a{};
                a.scale2 = 0.08838834764831845f * LOG2E;
                a.Q = QX + h * 128; a.qpitch = 512; a.K1 = MEMKV + layer * 1024 + h * 128; a.k1pitch = 2048; a.K2 = a.K1; a.k2pitch = 2048; a.V = MEMKV + layer * 1024 + 512 + h * 128; a.vpitch = 2048;
                a.O = OX + h * 128; a.opitch = 512; a.qrow0 = (long)b * S; a.kvrow0 = (long)b * MEMLEN; a.dil = 1; a.q0 = qb * 256; a.W = 0;
                a.tlo = 0; a.thi = 4; a.sink2 = -INFINITY; a.omode = 0; a.head = h;
                { u32x4 dk[6] = {}, dv[6] = {}; attn_unit<128, 128, 16, 0, 0>(lds, a, tid, dk, dv, false, false, a); }
            }
        } else if (st == 0) {
            LAS float* scr = (LAS float*)(lds + wave * 16384);
#define WJOB(W_, ldw_, K_, g_, Bt_, roff_, rbs_, ncols_, nphys_) { constexpr int cnt = ((K_) / 64) * ((nphys_) / 32); \
        if (r < cnt) { wt_item((const GAS float*)(W_), ldw_, K_, (const GAS float*)(g_), Bt_, roff_, rbs_, ncols_, (nphys_) / 32, r, scr, lane); continue; } r -= cnt; }
#define WJOBP(W_, ldw_, K_, g_, Bt_, roff_, rbs_, ncols_, nphys_, plo_, phi_) { constexpr int cnt = ((K_) / 64) * ((nphys_) / 32); \
        if (r < cnt) { wt_item((const GAS float*)(W_), ldw_, K_, (const GAS float*)(g_), Bt_, roff_, rbs_, ncols_, (nphys_) / 32, r, scr, lane, plo_, phi_); continue; } r -= cnt; }
            constexpr int NITEMS = (1024 / 64) * (1536 / 32) + (384 / 64) * (768 / 32) + (256 / 64) * (1024 / 32) + 16 * 32 + 16 * 16 + 16 * 32 + 8 * 32 + 2 * 16 * 88 + 44 * 32
                                 + 16 * 96 + 16 * 32 + 16 * 16 + 16 * 32 + 8 * 32 + 2 * 16 * 88 + 44 * 32;
            for (int it = gw; it < NITEMS; it += NGW) {
                int r = it;
                WJOB(PIN(4), 1440, 1024, PIN(3), WSB(W_IN), 0, 128, 1440, 1536)
                WJOB(PIN(7), 768, 384, PIN(6), WSB(W_UQ), 0, 128, 768, 768)
                WJOB(PIN(9), 1024, 256, PIN(8), WSB(W_UKV), 0, 128, 1024, 1024)
                WJOB(PIN(10), 1024, 1024, nullptr, WSB(W_OUT0), 0, 128, 1024, 1024)
                WJOB(PIN(13), 512, 1024, PIN(11), WSB(W_XQ0), 0, 128, 512, 512)
                WJOB(PIN(14), 1024, 1024, PIN(12), WSB(W_XKV), 0, 128, 1024, 1024)
                WJOB(PIN(15), 1024, 512, nullptr, WSB(W_XO0), 0, 128, 1024, 1024)
                WJOB(PIN(17), FF, 1024, PIN(16), WSB(W_GU0), 0, 256, FF, FF)
                WJOB(PIN(18), FF, 1024, PIN(16), WSB(W_GU0), 128, 256, FF, FF)
                WJOB(PIN(19), 1024, FF, nullptr, WSB(W_DN0), 0, 128, 1024, 1024)
                WJOBP(PIN(21), 3072, 1024, PIN(20), WSB(W_QKV), 0, 128, 3072, 3072, 0, 2048)
                WJOB(PIN(22), 1024, 1024, nullptr, WSB(W_OUT1), 0, 128, 1024, 1024)
                WJOB(PIN(25), 512, 1024, PIN(23), WSB(W_XQ1), 0, 128, 512, 512)
                WJOB(PIN(26), 1024, 1024, PIN(24), WSB(W_XKV), 1024, 128, 1024, 1024)
                WJOB(PIN(27), 1024, 512, nullptr, WSB(W_XO1), 0, 128, 1024, 1024)
                WJOB(PIN(29), FF, 1024, PIN(28), WSB(W_GU1), 0, 256, FF, FF)
                WJOB(PIN(30), FF, 1024, PIN(28), WSB(W_GU1), 128, 256, FF, FF)
                WJOB(PIN(31), 1024, FF, nullptr, WSB(W_DN1), 0, 128, 1024, 1024)
            }
#undef WJOB
#undef WJOBP
            for (int idx = bid * 512 + tid; idx < T * 32; idx += G * 512) {
                const int t = idx >> 5, i = idx & 31;
                const float invf = exp2f(-(float)i * (13.287712379549449f / 32.0f));
                const float af = (float)pos_in[t] * invf;
                float s, c; sincosf(af, &s, &c);
                R64C[idx] = c; R64S[idx] = s;
                if (!(i & 1)) { R32C[t * 16 + (i >> 1)] = c; R32S[t * 16 + (i >> 1)] = s; }
            }
            for (int m0 = gw; m0 < T; m0 += 4 * NGW) {
                f32x4 v[4][4];
#pragma unroll
                for (int r = 0; r < 4; ++r)
#pragma unroll
                    for (int j = 0; j < 4; ++j) v[r][j] = *((const GAS f32x4*)(x_in + (size_t)(m0 + r * NGW) * D) + lane + 64 * j);
#pragma unroll
                for (int r = 0; r < 4; ++r) { const int m = m0 + r * NGW; float s = 0.f;
#pragma unroll
                    for (int j = 0; j < 4; ++j) s += (v[r][j][0] * v[r][j][0] + v[r][j][1] * v[r][j][1]) + (v[r][j][2] * v[r][j][2] + v[r][j][3] * v[r][j][3]);
                    s = wave_sum(s);
                    GAS u32x2* o8 = (GAS u32x2*)(XB + (size_t)m * D) + lane;
#pragma unroll
                    for (int j = 0; j < 4; ++j) { u32x2 w; w.x = cvtpk(v[r][j][0], v[r][j][1]); w.y = cvtpk(v[r][j][2], v[r][j][3]); o8[64 * j] = w; }
                    if (lane < 16) SSQ[(size_t)m * 16 + lane] = lane == 0 ? s : 0.f; }
            }
            for (int m = gw; m < MROWS; m += NGW) row_to_bf16(mem_in + (size_t)m * D, MEMB + (size_t)m * D, MEMSSQ + (size_t)m * 16, lane);
        } else if (st == 3) {
            for (int t0 = gw; t0 < T; t0 += 4 * NGW) {
                u32x4 vq[4], vk[4], a1[4], a2[4]; f32x4 c0[4], c1[4], s0[4], s1[4];
                const int role = lane < 8 ? 0 : (lane < 10 ? 1 : 2);
                const int hd = (lane >> 2) & 1, q = lane & 3, q2 = lane & 1;
#pragma unroll
                for (int r = 0; r < 4; ++r) { const int t = t0 + r * NGW; GAS bf16_t* zr = BIG + (size_t)t * ZP;
                    vq[r] = *(const GAS u32x4*)(zr + Z_CQ + 8 * (lane < 48 ? lane : 0));
                    vk[r] = *(const GAS u32x4*)(zr + Z_CKV + 8 * (lane & 31));
                    const GAS bf16_t* p1 = role == 1 ? zr + Z_KR + 8 * q2 : zr + Z_KA + hd * 64 + 8 * q;
                    a1[r] = *(const GAS u32x4*)p1; a2[r] = *(const GAS u32x4*)(p1 + (role == 1 ? 16 : 32));
                    const GAS float* cb = role == 1 ? R32C + (size_t)t * 16 + 8 * q2 : R64C + (size_t)t * 32 + 8 * q;
                    const GAS float* sb = role == 1 ? R32S + (size_t)t * 16 + 8 * q2 : R64S + (size_t)t * 32 + 8 * q;
                    c0[r] = *(const GAS f32x4*)cb; c1[r] = *(const GAS f32x4*)(cb + 4); s0[r] = *(const GAS f32x4*)sb; s1[r] = *(const GAS f32x4*)(sb + 4); }
#pragma unroll
                for (int r = 0; r < 4; ++r) { const int t = t0 + r * NGW; GAS bf16_t* zr = BIG + (size_t)t * ZP;
                    float f[8]; unpack8(vq[r], f); float sq = 0.f;
#pragma unroll
                    for (int j = 0; j < 8; ++j) sq += f[j] * f[j];
                    sq = lane < 48 ? sq : 0.f;
                    unpack8(vk[r], f); float sk = 0.f;
#pragma unroll
                    for (int j = 0; j < 8; ++j) sk += f[j] * f[j];
                    sk = lane < 32 ? sk : 0.f;
                    sq = wave_sum(sq); sk = wave_sum(sk);
                    if (lane < 16) { SSQQ[(size_t)t * 16 + lane] = lane == 0 ? sq : 0.f; SSQKV[(size_t)t * 16 + lane] = lane == 0 ? sk : 0.f; }
                    if (role < 2) {
                        float x1[8], x2[8], y1[8], y2[8]; unpack8(a1[r], x1); unpack8(a2[r], x2);
#pragma unroll
                        for (int j = 0; j < 8; ++j) { const float c = j < 4 ? c0[r][j & 3] : c1[r][j & 3], s = j < 4 ? s0[r][j & 3] : s1[r][j & 3]; y1[j] = x1[j] * c - x2[j] * s; y2[j] = x2[j] * c + x1[j] * s; }
                        GAS bf16_t* p1 = role == 1 ? zr + Z_KR + 8 * q2 : zr + Z_KA + hd * 64 + 8 * q;
                        *(GAS bf16x8*)p1 = pack8(y1); *(GAS bf16x8*)(p1 + (role == 1 ? 16 : 32)) = pack8(y2);
                    }
                }
            }
        } else if (st == 25) {
            const GAS float* gfin = (const GAS float*)PIN(32);
            const GAS _Float16* X16 = (const GAS _Float16*)WSB(O_OB);
            typedef _Float16 f16x8 __attribute__((ext_vector_type(8)));
            f32x4 gv[2][2];
#pragma unroll
            for (int j = 0; j < 2; ++j) { gv[j][0] = *(const GAS f32x4*)(gfin + j * 512 + 8 * lane); gv[j][1] = *(const GAS f32x4*)(gfin + j * 512 + 8 * lane + 4); }
            for (int t0 = gw; t0 < T; t0 += 4 * NGW) {
                f16x8 h[4][2]; f32x4 pr[4][4];
#pragma unroll
                for (int r = 0; r < 4; ++r) { const int t = t0 + r * NGW;
#pragma unroll
                    for (int j = 0; j < 2; ++j) h[r][j] = *(const GAS f16x8*)(X16 + (size_t)t * D + j * 512 + 8 * lane);
#pragma unroll
                    for (int j = 0; j < 4; ++j) pr[r][j] = *(const GAS f32x4*)(SSQ + (size_t)t * 16 + 4 * j); }
#pragma unroll
                for (int r = 0; r < 4; ++r) { const int t = t0 + r * NGW;
                    float s = 0.f;
#pragma unroll
                    for (int j = 0; j < 4; ++j) s += (pr[r][j][0] + pr[r][j][1]) + (pr[r][j][2] + pr[r][j][3]);
                    const float rs = __builtin_amdgcn_rsqf(s * (1.f / D) + EPS);
#pragma unroll
                    for (int j = 0; j < 2; ++j) {
                        const f32x4 v0 = (f32x4){(float)h[r][j][0], (float)h[r][j][1], (float)h[r][j][2], (float)h[r][j][3]} * rs * gv[j][0];
                        const f32x4 v1 = (f32x4){(float)h[r][j][4], (float)h[r][j][5], (float)h[r][j][6], (float)h[r][j][7]} * rs * gv[j][1];
                        GAS float* op = X + (size_t)t * D + j * 512 + 8 * lane;
                        *(GAS f32x4*)op = v0; *(GAS f32x4*)(op + 4) = v1; }
                }
            }
        }
        if ((sync_after || (REPEAT_MASK >> st) & 1u) && st + 1 < P.hi) {
            xcd_barrier(xbar);
        }
    }
}

constexpr int LDS_BYTES = 163840;
constexpr int NSTEPS = 26;

extern "C" void kernel_launch(void* const* d_in, const int* in_sizes, int n_in, void* d_out, int out_size, void* d_ws, size_t ws_size, hipStream_t stream) {
    static int grid_blocks = 0;
    if (!grid_blocks) {
        if (n_in != 33 || out_size != T * D || ws_size < WS_NEED * MiB) { fprintf(stderr, "kernel_launch: unexpected shapes n_in=%d out=%d ws=%zu\n", n_in, out_size, ws_size); grid_blocks = -1; return; }
        int dev = 0, cus = 0, per_cu = 0;
        hipGetDevice(&dev);
        hipDeviceGetAttribute(&cus, hipDeviceAttributeMultiprocessorCount, dev);
        hipFuncSetAttribute((const void*)fwd_kernel, hipFuncAttributeMaxDynamicSharedMemorySize, LDS_BYTES);
        hipOccupancyMaxActiveBlocksPerMultiprocessor(&per_cu, (const void*)fwd_kernel, 512, LDS_BYTES);
        if (per_cu < 1) per_cu = 1;
        grid_blocks = cus * per_cu;
        (void)hipGetLastError();
    }
    if (grid_blocks < 0) return;
    Params p{};
    for (int i = 0; i < 33; ++i) p.in[i] = d_in[i];
    p.out = (float*)d_out; p.ws = (unsigned char*)d_ws; p.lo = 0; p.hi = NSTEPS;
    (void)hipMemsetAsync(d_ws, 0, 16384, stream);
    void* args[] = {&p};
    hipError_t e = hipLaunchCooperativeKernel((const void*)fwd_kernel, dim3(grid_blocks), dim3(512), args, LDS_BYTES, stream);
    if (e != hipSuccess) fprintf(stderr, "cooperative launch failed: %s (grid %d)\n", hipGetErrorString(e), grid_blocks);
}
```

```cpp
#include <hip/hip_runtime.h>
#include <hip/hip_cooperative_groups.h>
#include <cstdio>
#include <cstdint>
#include <cmath>
namespace cg = cooperative_groups;

#define LAS __attribute__((address_space(3)))
#define GAS __attribute__((address_space(1)))
#define DI __device__ __forceinline__
typedef unsigned short bf16_t;
typedef short bf16x8 __attribute__((ext_vector_type(8)));
typedef short s16x4 __attribute__((ext_vector_type(4)));
typedef float f32x2 __attribute__((ext_vector_type(2)));
typedef float f32x4 __attribute__((ext_vector_type(4)));
typedef float f32x16 __attribute__((ext_vector_type(16)));
typedef unsigned u32x2 __attribute__((ext_vector_type(2)));
typedef unsigned u32x4 __attribute__((ext_vector_type(4)));
typedef __bf16 bf16x2_t __attribute__((ext_vector_type(2)));

constexpr int NB = 8, S = 8192, T = NB * S, D = 1024, MEMLEN = 256, MROWS = NB * MEMLEN;
constexpr int ZP = 1536;
constexpr int Z_KA = 512, Z_VA = 640, Z_CQ = 768, Z_CKV = 1152, Z_KR = 1408;
constexpr int FF = 2816;
constexpr float EPS = 1e-6f;
constexpr float LOG2E = 1.4426950408889634f;

constexpr size_t MiB = 1u << 20;
constexpr size_t W_IN = 1, W_UQ = 4, W_UKV = 5, W_OUT0 = 6, W_XQ0 = 8, W_XKV = 9, W_XO0 = 13, W_GU0 = 14, W_DN0 = 25,
                 W_QKV = 31, W_OUT1 = 37, W_XQ1 = 39, W_XO1 = 40, W_GU1 = 41, W_DN1 = 52,
                 O_R64C = 58, O_R64S = 66, O_R32C = 74, O_R32S = 78, O_SSQ = 82, O_SSQQ = 86, O_SSQKV = 90, O_MEMSSQ = 94,
                 O_MEMB = 95, O_MEMKV = 99, O_LSE1 = 107, O_LSE2 = 111, O_XB = 116, O_BIG = 244, O_R1 = 628, O_R2 = 756, O_OB = 884,
                 WS_NEED = 1012;

DI unsigned cvtpk(float lo, float hi) { f32x2 v = {lo, hi}; bf16x2_t b = __builtin_convertvector(v, bf16x2_t); return __builtin_bit_cast(unsigned, b); }
DI float bflo(unsigned u) { return __uint_as_float(u << 16); }
DI float bfhi(unsigned u) { return __uint_as_float(u & 0xffff0000u); }
DI float bf2f(bf16_t h) { return __uint_as_float(((unsigned)h) << 16); }
DI bf16_t f2bf(float f) { return (bf16_t)(cvtpk(f, 0.f) & 0xffffu); }
DI float wave_sum(float v) {
#pragma unroll
    for (int o = 1; o < 64; o <<= 1) v += __shfl_xor(v, o);
    return v;
}

namespace pg8 {
constexpr int BM = 256, BK = 64, HALF = 128, HTB = HALF * BK * 2, NXCD = 8, WGM = 8;
DI int lds_byte(int r, int c) { const int st = (r >> 4) * 2 + (c >> 5), rr = r & 15, cc = c & 31, ob = rr * 64 + cc * 2; return st * 1024 + (ob ^ (((ob >> 9) & 1) << 5)); }
DI void stage_rc(int b, int& R, int& C) { const int st = b / 1024, sb = b % 1024, swz = sb ^ (((sb >> 9) & 1) << 5); R = (st >> 1) * 16 + swz / 64; C = (st & 1) * 32 + (swz % 64) / 2; }
DI int perm32(int rho) { const int n = rho >> 4, i = rho & 15; return 8 * (i >> 2) + 4 * n + (i & 3); }
struct Unit { int pm, pn; };
struct Gemm { const GAS bf16_t* A; const GAS bf16_t* Bt; int M, N, K, lda; };
struct StaticOrder {
    int nM, nN, nwg, G, c;
    DI void init(int M, int N, int G_, int c_) { nM = M / BM; nN = N / BM; nwg = nM * nN; G = G_; c = c_; }
    DI bool next(int i, Unit& u) const {
        const long L = (long)i * G + c; if (L >= nwg) return false;
        int wgid = (int)L; { const int q = nwg / NXCD, r = nwg % NXCD, xcd = wgid % NXCD, off = wgid / NXCD; wgid = (xcd < r ? xcd * (q + 1) : r * (q + 1) + (xcd - r) * q) + off; }
        const int nig = WGM * nN, gid = wgid / nig, fm = gid * WGM, gsz = (nM - fm) < WGM ? (nM - fm) : WGM;
        u.pm = fm + ((wgid % nig) % gsz); u.pn = (wgid % nig) / gsz; return true;
    }
};

typedef _Float16 f16x4 __attribute__((ext_vector_type(4)));
struct EpiP { GAS bf16_t* O; int ldc; const GAS float* ssq; float inv_dim; const GAS float* Xin; GAS float* Xout; GAS bf16_t* XB; GAS float* ssq_out; GAS _Float16* X16; const GAS float* rc; const GAS float* rs; int rope_lo, rope_hi; };

DI float row_rstd(const GAS float* ssq, float inv_dim, int row) {
    const GAS f32x4* p = (const GAS f32x4*)(ssq + (size_t)row * 16);
    const f32x4 a = p[0], b = p[1], c = p[2], d = p[3];
    const float s = ((a[0] + a[1]) + (a[2] + a[3])) + ((b[0] + b[1]) + (b[2] + b[3])) + ((c[0] + c[1]) + (c[2] + c[3])) + ((d[0] + d[1]) + (d[2] + d[3]));
    return __builtin_amdgcn_rsqf(s * inv_dim + EPS);
}
DI void rows_rstd(const GAS float* ssq, float inv_dim, int row0, int fq, float (&rs)[2][4]) {
    f32x4 pr[2][4];
#pragma unroll
    for (int ai = 0; ai < 2; ++ai)
#pragma unroll
        for (int m = 0; m < 4; ++m) pr[ai][m] = *(const GAS f32x4*)(ssq + (size_t)(row0 + ai * HALF + m * 16) * 16 + 4 * fq);
#pragma unroll
    for (int ai = 0; ai < 2; ++ai)
#pragma unroll
        for (int m = 0; m < 4; ++m) { float s = (pr[ai][m][0] + pr[ai][m][1]) + (pr[ai][m][2] + pr[ai][m][3]); s += __shfl_xor(s, 16); s += __shfl_xor(s, 32); rs[ai][m] = __builtin_amdgcn_rsqf(s * inv_dim + EPS); }
}
struct EpiScale {
    static constexpr bool PERM = true; EpiP p;
    DI void operator()(const f32x4 (&acc)[2][2][4][2], const Unit& u, int wr, int wc, int fr, int fq) const {
        const int row0 = u.pm * BM + wr * 64 + fr, col0 = u.pn * BM + wc * 32 + 8 * fq;
        float rs[2][4]; rows_rstd(p.ssq, p.inv_dim, row0, fq, rs);
#pragma unroll
        for (int ai = 0; ai < 2; ++ai)
#pragma unroll
            for (int m = 0; m < 4; ++m) {
                const int row = row0 + ai * HALF + m * 16; const float r = rs[ai][m];
                GAS bf16_t* rowp = p.O + (size_t)row * p.ldc + col0;
#pragma unroll
                for (int bj = 0; bj < 2; ++bj) { const f32x4 v0 = acc[ai][bj][m][0] * r, v1 = acc[ai][bj][m][1] * r;
                    u32x4 w; w.x = cvtpk(v0[0], v0[1]); w.y = cvtpk(v0[2], v0[3]); w.z = cvtpk(v1[0], v1[1]); w.w = cvtpk(v1[2], v1[3]);
                    *(GAS u32x4*)(rowp + bj * HALF) = w; }
            }
    }
};
struct EpiScaleRope {
    static constexpr bool PERM = true; EpiP p;
    DI size_t hm(int row, int sec, int h) const { return ((size_t)sec * T * 16 + (size_t)(row >> 13) * (16 * S) + (size_t)h * S + (row & (S - 1))) * 64; }
    DI void operator()(const f32x4 (&acc)[2][2][4][2], const Unit& u, int wr, int wc, int fr, int fq) const {
        const int row0 = u.pm * BM + wr * 64 + fr;
        float rs[2][4]; rows_rstd(p.ssq, p.inv_dim, row0, fq, rs);
        const int sec = u.pn >> 2;
        if (u.pn >= p.rope_lo && u.pn < p.rope_hi) {
            const int h = 4 * (u.pn & 3) + wc;
            const float qs = (sec == 0) ? 0.125f * LOG2E : 1.f;
#pragma unroll
            for (int g2 = 0; g2 < 4; ++g2) {
                f32x4 cv[2][2], sv[2][2];
#pragma unroll
                for (int mm = 0; mm < 2; ++mm) { const int ai = g2 >> 1, m = (g2 & 1) * 2 + mm; const size_t tb = (size_t)(row0 + ai * HALF + m * 16) * 32 + 8 * fq;
                    cv[mm][0] = *(const GAS f32x4*)(p.rc + tb); cv[mm][1] = *(const GAS f32x4*)(p.rc + tb + 4); sv[mm][0] = *(const GAS f32x4*)(p.rs + tb); sv[mm][1] = *(const GAS f32x4*)(p.rs + tb + 4); }
                __builtin_amdgcn_sched_barrier(0);
#pragma unroll
                for (int mm = 0; mm < 2; ++mm) { const int ai = g2 >> 1, m = (g2 & 1) * 2 + mm;
                    const int row = row0 + ai * HALF + m * 16; const float r = rs[ai][m] * qs;
                    const f32x4 a0 = acc[ai][0][m][0] * r, a1 = acc[ai][0][m][1] * r, b0 = acc[ai][1][m][0] * r, b1 = acc[ai][1][m][1] * r;
                    const f32x4 l0 = a0 * cv[mm][0] - b0 * sv[mm][0], l1 = a1 * cv[mm][1] - b1 * sv[mm][1];
                    const f32x4 h0 = b0 * cv[mm][0] + a0 * sv[mm][0], h1 = b1 * cv[mm][1] + a1 * sv[mm][1];
                    GAS bf16_t* rowp = p.O + hm(row, sec, h) + 8 * fq;
                    u32x4 w; w.x = cvtpk(l0[0], l0[1]); w.y = cvtpk(l0[2], l0[3]); w.z = cvtpk(l1[0], l1[1]); w.w = cvtpk(l1[2], l1[3]); *(GAS u32x4*)rowp = w;
                    w.x = cvtpk(h0[0], h0[1]); w.y = cvtpk(h0[2], h0[3]); w.z = cvtpk(h1[0], h1[1]); w.w = cvtpk(h1[2], h1[3]); *(GAS u32x4*)(rowp + 32) = w;
                }
            }
        } else {
#pragma unroll
            for (int ai = 0; ai < 2; ++ai)
#pragma unroll
                for (int m = 0; m < 4; ++m) {
                    const int row = row0 + ai * HALF + m * 16; const float r = rs[ai][m];
#pragma unroll
                    for (int bj = 0; bj < 2; ++bj) { const f32x4 v0 = acc[ai][bj][m][0] * r, v1 = acc[ai][bj][m][1] * r;
                        u32x4 w; w.x = cvtpk(v0[0], v0[1]); w.y = cvtpk(v0[2], v0[3]); w.z = cvtpk(v1[0], v1[1]); w.w = cvtpk(v1[2], v1[3]);
                        const int h = 4 * (u.pn & 3) + 2 * bj + (wc >> 1);
                        *(GAS u32x4*)(p.O + hm(row, sec, h) + 32 * (wc & 1) + 8 * fq) = w; }
                }
        }
    }
};
DI float silu_mul(float g, float u) { return g * __builtin_amdgcn_rcpf(1.f + __builtin_amdgcn_exp2f(-g * LOG2E)) * u; }
struct EpiSwiglu {
    static constexpr bool PERM = true; EpiP p;
    DI void operator()(const f32x4 (&acc)[2][2][4][2], const Unit& u, int wr, int wc, int fr, int fq) const {
        const int row0 = u.pm * BM + wr * 64 + fr, col0 = u.pn * HALF + wc * 32 + 8 * fq;
        float rs[2][4]; rows_rstd(p.ssq, p.inv_dim, row0, fq, rs);
#pragma unroll
        for (int ai = 0; ai < 2; ++ai)
#pragma unroll
            for (int m = 0; m < 4; ++m) {
                const int row = row0 + ai * HALF + m * 16; const float r = rs[ai][m];
                const f32x4 g0 = acc[ai][0][m][0] * r, g1 = acc[ai][0][m][1] * r, u0 = acc[ai][1][m][0] * r, u1 = acc[ai][1][m][1] * r;
                u32x4 w; w.x = cvtpk(silu_mul(g0[0], u0[0]), silu_mul(g0[1], u0[1])); w.y = cvtpk(silu_mul(g0[2], u0[2]), silu_mul(g0[3], u0[3]));
                w.z = cvtpk(silu_mul(g1[0], u1[0]), silu_mul(g1[1], u1[1])); w.w = cvtpk(silu_mul(g1[2], u1[2]), silu_mul(g1[3], u1[3]));
                *(GAS u32x4*)(p.O + (size_t)row * p.ldc + col0) = w;
            }
    }
};
template <int MODE>
struct EpiResid {
    static constexpr bool PERM = true; EpiP p;
    DI void operator()(const f32x4 (&acc)[2][2][4][2], const Unit& u, int wr, int wc, int fr, int fq) const {
        typedef _Float16 f16x8 __attribute__((ext_vector_type(8)));
        const int row0 = u.pm * BM + wr * 64 + fr, col0 = u.pn * BM + wc * 32 + 8 * fq;
#pragma unroll
        for (int ai = 0; ai < 2; ++ai) {
            f32x4 xin[4][2][2];
#pragma unroll
            for (int m = 0; m < 4; ++m)
#pragma unroll
                for (int bj = 0; bj < 2; ++bj) { const size_t o2 = (size_t)(row0 + ai * HALF + m * 16) * D + col0 + bj * HALF;
                    if (MODE == 0) { xin[m][bj][0] = *(const GAS f32x4*)(p.Xin + o2); xin[m][bj][1] = *(const GAS f32x4*)(p.Xin + o2 + 4); }
                    else { const f16x8 h = *(const GAS f16x8*)(p.X16 + o2); xin[m][bj][0] = (f32x4){(float)h[0], (float)h[1], (float)h[2], (float)h[3]}; xin[m][bj][1] = (f32x4){(float)h[4], (float)h[5], (float)h[6], (float)h[7]}; } }
            __builtin_amdgcn_sched_barrier(0);
#pragma unroll
            for (int m = 0; m < 4; ++m) {
                const int row = row0 + ai * HALF + m * 16; const size_t off = (size_t)row * D + col0; float ss = 0.f;
#pragma unroll
                for (int bj = 0; bj < 2; ++bj) { const size_t o2 = off + bj * HALF;
                    const f32x4 v0 = xin[m][bj][0] + acc[ai][bj][m][0], v1 = xin[m][bj][1] + acc[ai][bj][m][1];
                    { const f16x8 h = {(_Float16)v0[0], (_Float16)v0[1], (_Float16)v0[2], (_Float16)v0[3], (_Float16)v1[0], (_Float16)v1[1], (_Float16)v1[2], (_Float16)v1[3]}; *(GAS f16x8*)(p.X16 + o2) = h; }
                    if (MODE != 2) { u32x4 w; w.x = cvtpk(v0[0], v0[1]); w.y = cvtpk(v0[2], v0[3]); w.z = cvtpk(v1[0], v1[1]); w.w = cvtpk(v1[2], v1[3]); *(GAS u32x4*)(p.XB + o2) = w; }
                    ss += ((v0[0] * v0[0] + v0[1] * v0[1]) + (v0[2] * v0[2] + v0[3] * v0[3])) + ((v1[0] * v1[0] + v1[1] * v1[1]) + (v1[2] * v1[2] + v1[3] * v1[3])); }
                ss += __shfl_xor(ss, 16); ss += __shfl_xor(ss, 32);
                if (fq == 0) p.ssq_out[(size_t)row * 16 + u.pn * 4 + wc] = ss;
            }
        }
    }
};

template <class Epi>
DI void gemm_phase(LAS unsigned char* lds, const Gemm g, const StaticOrder& S, const Epi& E, const int tid) {
    const int wid = __builtin_amdgcn_readfirstlane(tid >> 6), lane = tid & 63, wr = wid >> 2, wc = wid & 3, fr = lane & 15, fq = lane >> 4;
    const int K = g.K, nt = K / BK, lda = g.lda;
    unsigned voffA[2], voffB[2];
#pragma unroll
    for (int i = 0; i < 2; ++i) { int R, C; stage_rc(tid * 16 + i * 8192, R, C); const int Rb = Epi::PERM ? ((R & ~31) + perm32(R & 31)) : R;
        voffA[i] = (unsigned)(R * lda + C) * 2u; voffB[i] = (unsigned)(Rb * K + C) * 2u; }
    const size_t kstep = (size_t)(BK * 2);
    const size_t hstepA = (size_t)HALF * lda * 2, hstepB = (size_t)HALF * K * 2;
    const size_t tstepA = 2 * hstepA, tstepB = 2 * hstepB;
    const unsigned ldsw = (unsigned)wid * 1024u;
    const int aoff = lds_byte(wr * 64 + fr, fq * 8), boff = lds_byte(wc * 32 + fr, fq * 8);
#define PG8_SA(b, h) (((b) * 2 + (h)) * HTB)
#define PG8_SB(b, h) ((4 + (b) * 2 + (h)) * HTB)
#define PG8_STAGE(bufoff, gbase, voff) do { _Pragma("unroll") for (int _i = 0; _i < 2; ++_i) \
        __builtin_amdgcn_global_load_lds((const GAS unsigned*)((const GAS char*)(gbase) + (voff)[_i]), (LAS unsigned*)(lds + (bufoff) + ldsw + _i * 8192), 16, 0, 0); } while (0)
#define PG8_LDA(dst, b, h) do { _Pragma("unroll") for (int m = 0; m < 4; ++m) _Pragma("unroll") for (int k = 0; k < 2; ++k) dst[m][k] = *(const LAS bf16x8*)(lds + PG8_SA(b, h) + aoff + m * 2048 + k * 1024); } while (0)
#define PG8_LDB(dst, b, h) do { _Pragma("unroll") for (int n = 0; n < 2; ++n) _Pragma("unroll") for (int k = 0; k < 2; ++k) dst[n][k] = *(const LAS bf16x8*)(lds + PG8_SB(b, h) + boff + n * 2048 + k * 1024); } while (0)
#define PG8_MMA(ai, bj, At, Bt) do { __builtin_amdgcn_s_setprio(1); _Pragma("unroll") for (int m = 0; m < 4; ++m) _Pragma("unroll") for (int n = 0; n < 2; ++n) _Pragma("unroll") for (int k = 0; k < 2; ++k) \
        acc[ai][bj][m][n] = __builtin_amdgcn_mfma_f32_16x16x32_bf16(Bt[n][k], At[m][k], acc[ai][bj][m][n], 0, 0, 0); __builtin_amdgcn_s_setprio(0); } while (0)
#define PG8_WAIT_V(n) asm volatile("s_waitcnt vmcnt(" #n ")" ::: "memory")
#define PG8_WAIT_L(n) asm volatile("s_waitcnt lgkmcnt(" #n ")" ::: "memory")
#define PG8_BAR __builtin_amdgcn_s_barrier()
#define PG8_SCHED __builtin_amdgcn_sched_barrier(0)
    Unit cur, nxt; int ui = 0;
    if (!S.next(0, cur)) return;
    f32x4 acc[2][2][4][2];
#pragma unroll
    for (int a = 0; a < 2; ++a)
#pragma unroll
        for (int b = 0; b < 2; ++b)
#pragma unroll
            for (int m = 0; m < 4; ++m)
#pragma unroll
                for (int n = 0; n < 2; ++n) acc[a][b][m][n] = (f32x4){0.f, 0.f, 0.f, 0.f};
    bf16x8 At[4][2], B0[2][2], B1[2][2];
    const GAS char* cA = (const GAS char*)g.A + (size_t)cur.pm * tstepA; const GAS char* cB = (const GAS char*)g.Bt + (size_t)cur.pn * tstepB;
    PG8_STAGE(PG8_SB(0, 0), cB, voffB); PG8_STAGE(PG8_SB(0, 1), cB + hstepB, voffB); PG8_STAGE(PG8_SA(0, 0), cA, voffA); PG8_STAGE(PG8_SA(0, 1), cA + hstepA, voffA);
    if (wr == 1) PG8_BAR;
    PG8_WAIT_V(2); PG8_BAR;
    PG8_STAGE(PG8_SB(1, 0), cB + kstep, voffB); PG8_STAGE(PG8_SA(1, 0), cA + kstep, voffA); PG8_STAGE(PG8_SB(1, 1), cB + hstepB + kstep, voffB);
    PG8_WAIT_V(6); PG8_BAR;
    for (;;) {
        const bool has_next = S.next(ui + 1, nxt);
        const GAS char* nA = has_next ? (const GAS char*)g.A + (size_t)nxt.pm * tstepA : cA; const GAS char* nB = has_next ? (const GAS char*)g.Bt + (size_t)nxt.pn * tstepB : cB;
        for (int t = 0; t < nt; t += 2) {
            const bool last = (t == nt - 2);
            const GAS char* a1 = cA + (size_t)(t + 1) * kstep;
            const GAS char* a2 = last ? nA : cA + (size_t)(t + 2) * kstep; const GAS char* b2 = last ? nB : cB + (size_t)(t + 2) * kstep;
            const GAS char* a3 = a2 + kstep; const GAS char* b3 = b2 + kstep;
            PG8_LDB(B0, 0, 0); PG8_LDB(B1, 0, 1); PG8_SCHED; PG8_LDA(At, 0, 0); PG8_STAGE(PG8_SA(1, 1), a1 + hstepA, voffA);
            PG8_WAIT_V(8); PG8_WAIT_L(0); PG8_BAR; PG8_MMA(0, 0, At, B0); PG8_MMA(0, 1, At, B1); PG8_BAR; PG8_SCHED;
            PG8_LDA(At, 0, 1); PG8_STAGE(PG8_SB(0, 0), b2, voffB); PG8_STAGE(PG8_SB(0, 1), b2 + hstepB, voffB); PG8_STAGE(PG8_SA(0, 0), a2, voffA);
            PG8_WAIT_V(8); PG8_WAIT_L(0); PG8_BAR; PG8_MMA(1, 0, At, B0); PG8_MMA(1, 1, At, B1); PG8_BAR; PG8_SCHED;
            PG8_LDB(B0, 1, 0); PG8_LDB(B1, 1, 1); PG8_SCHED; PG8_LDA(At, 1, 0); PG8_STAGE(PG8_SA(0, 1), a2 + hstepA, voffA);
            PG8_WAIT_V(8); PG8_WAIT_L(0); PG8_BAR; PG8_MMA(0, 0, At, B0); PG8_MMA(0, 1, At, B1); PG8_BAR; PG8_SCHED;
            PG8_LDA(At, 1, 1); PG8_STAGE(PG8_SB(1, 0), b3, voffB); PG8_STAGE(PG8_SB(1, 1), b3 + hstepB, voffB); PG8_STAGE(PG8_SA(1, 0), a3, voffA);
            PG8_WAIT_V(8); PG8_WAIT_L(0); PG8_BAR; PG8_MMA(1, 0, At, B0); PG8_MMA(1, 1, At, B1); PG8_BAR; PG8_SCHED;
        }
        if (wr == 0) PG8_BAR;
        E(acc, cur, wr, wc, fr, fq);
        if (!has_next) break;
#pragma unroll
        for (int a = 0; a < 2; ++a)
#pragma unroll
            for (int b = 0; b < 2; ++b)
#pragma unroll
                for (int m = 0; m < 4; ++m)
#pragma unroll
                    for (int n = 0; n < 2; ++n) acc[a][b][m][n] = (f32x4){0.f, 0.f, 0.f, 0.f};
        cur = nxt; cA = nA; cB = nB; ++ui;
        if (wr == 1) PG8_BAR;
    }
    PG8_WAIT_V(0);
    PG8_BAR;
#undef PG8_SA
#undef PG8_SB
#undef PG8_STAGE
#undef PG8_LDA
#undef PG8_LDB
#undef PG8_MMA
#undef PG8_WAIT_V
#undef PG8_WAIT_L
#undef PG8_BAR
#undef PG8_SCHED
}
}

struct AttnArgs {
    const GAS bf16_t* Q; int qpitch;
    const GAS bf16_t* K1; int k1pitch;
    const GAS bf16_t* K2; int k2pitch;
    const GAS bf16_t* V; int vpitch;
    GAS bf16_t* O; int opitch;
    long qrow0, kvrow0; int dil;
    int q0, tlo, thi, W;
    float scale2, sink2;
    const GAS float* rc; const GAS float* rs;
    int omode;
    GAS float* lse_out; const GAS float* lse_a; const GAS float* lse_b; const GAS bf16_t* Oa; const GAS bf16_t* Ob; int head;
};
DI int crow(int r, int hi) { return (r & 3) + 8 * (r >> 2) + 4 * hi; }
DI void unpack8(const u32x4 r, float (&f)[8]) { f[0] = bflo(r.x); f[1] = bfhi(r.x); f[2] = bflo(r.y); f[3] = bfhi(r.y); f[4] = bflo(r.z); f[5] = bfhi(r.z); f[6] = bflo(r.w); f[7] = bfhi(r.w); }
DI bf16x8 pack8(const float (&f)[8]) { u32x4 w; w.x = cvtpk(f[0], f[1]); w.y = cvtpk(f[2], f[3]); w.z = cvtpk(f[4], f[5]); w.w = cvtpk(f[6], f[7]); return __builtin_bit_cast(bf16x8, w); }
typedef short v4i16_t __attribute__((ext_vector_type(4)));
DI s16x4 vtr(LAS const unsigned char* p) { return __builtin_bit_cast(s16x4, __builtin_amdgcn_ds_read_tr16_b64_v4i16((LAS v4i16_t*)p)); }

template <int DQK, int DV, int MASK>
DI void attn_tile(const LAS unsigned char* kb, const LAS unsigned char* vb, const bf16x8 (&qf)[DQK / 16], f32x16 (&o)[DV / 32], float& m, float& l, f32x16& negm, const bool fast,
                  const int t, const int qn, const int qw0, const int half, const int W) {
    constexpr int KSTR = DQK * 2 + 16, VSTR = DV * 2 + 64, NS = DQK / 16, ND = DV / 32;
            constexpr bool FIXREF = (DV / 32 <= 2);
            f32x16 x0, x1;
            if (FIXREF && fast) { x0 = negm; x1 = negm; }
            else {
#pragma unroll
                for (int r = 0; r < 16; ++r) { x0[r] = 0.f; x1[r] = 0.f; }
            }
            constexpr int KCH_STEPS = (NS > 6) ? 2 : NS;
            constexpr bool VPRE = (ND <= 2);
#pragma unroll
            for (int c0 = 0; c0 < NS; c0 += KCH_STEPS) {
                bf16x8 ka[KCH_STEPS], kc[KCH_STEPS];
#pragma unroll
                for (int s = 0; s < KCH_STEPS; ++s) { ka[s] = *(const LAS bf16x8*)(kb + (c0 + s) * 32); kc[s] = *(const LAS bf16x8*)(kb + 32 * KSTR + (c0 + s) * 32); }
                __builtin_amdgcn_sched_barrier(0);
                __builtin_amdgcn_s_setprio(1);
#pragma unroll
                for (int s = 0; s < KCH_STEPS; ++s) {
                    x0 = __builtin_amdgcn_mfma_f32_32x32x16_bf16(ka[s], qf[c0 + s], x0, 0, 0, 0);
                    x1 = __builtin_amdgcn_mfma_f32_32x32x16_bf16(kc[s], qf[c0 + s], x1, 0, 0, 0);
                }
                __builtin_amdgcn_s_setprio(0);
                __builtin_amdgcn_sched_barrier(0);
            }
            s16x4 vl[4], vh[4];
            if (VPRE) {
#pragma unroll
                for (int s = 0; s < 4; ++s) { vl[s] = vtr(vb + (16 * s) * VSTR); vh[s] = vtr(vb + (16 * s + 8) * VSTR); }
                __builtin_amdgcn_sched_barrier(0);
            }
            if (MASK != 0) {
                const bool need = (MASK == 1) ? (t * 64 + 63 > qw0) : !((t * 64 + 63 <= qw0) && (qw0 + 31 - t * 64 <= W));
                if (need) {
                    const int dbase = qn - (t * 64 + 4 * half);
#pragma unroll
                    for (int r = 0; r < 16; ++r) { const int d0 = dbase - ((r & 3) + 8 * (r >> 2)), d1 = d0 - 32;
                        const bool v0 = (MASK == 1) ? (d0 >= 0) : ((unsigned)d0 <= (unsigned)W), v1 = (MASK == 1) ? (d1 >= 0) : ((unsigned)d1 <= (unsigned)W);
                        x0[r] = v0 ? x0[r] : -INFINITY; x1[r] = v1 ? x1[r] : -INFINITY; }
                }
            }
            if (!(FIXREF && fast)) {
            float mx;
            {
#define MX3(a, b, c) __builtin_fmaxf(__builtin_fmaxf((a), (b)), (c))
                float ma = MX3(x0[0], x0[1], x1[0]), mb = MX3(x0[2], x0[3], x1[1]); ma = MX3(ma, x1[2], x1[3]);
#pragma unroll
                for (int r = 4; r < 16; r += 4) { ma = MX3(ma, x0[r], x0[r + 1]); mb = MX3(mb, x0[r + 2], x0[r + 3]); ma = MX3(ma, x1[r], x1[r + 1]); mb = MX3(mb, x1[r + 2], x1[r + 3]); }
#undef MX3
                mx = fmaxf(ma, mb);
            }
            mx = fmaxf(mx, __shfl_xor(mx, 32));
            const float mn = fmaxf(m, mx), ms = (mn == -INFINITY) ? 0.f : mn;
            if (__any(mn > m)) {
                const float alpha = __builtin_amdgcn_exp2f(m - ms);
                l *= alpha;
#pragma unroll
                for (int d = 0; d < ND; ++d)
#pragma unroll
                    for (int r = 0; r < 16; ++r) o[d][r] *= alpha;
            }
            m = mn;
            float rsum = 0.f;
#pragma unroll
            for (int r = 0; r < 16; ++r) { x0[r] = __builtin_amdgcn_exp2f(x0[r] - ms); x1[r] = __builtin_amdgcn_exp2f(x1[r] - ms); rsum += x0[r] + x1[r]; }
            l += rsum;
            if (FIXREF) {
                m = ms;
#pragma unroll
                for (int r = 0; r < 16; ++r) negm[r] = -ms;
            }
            } else {
                float rsum = 0.f;
#pragma unroll
                for (int r = 0; r < 16; ++r) { x0[r] = __builtin_amdgcn_exp2f(x0[r]); x1[r] = __builtin_amdgcn_exp2f(x1[r]); rsum += x0[r] + x1[r]; }
                l += rsum;
            }
            bf16x8 pk[4];
            { u32x4 w;
              w.x = cvtpk(x0[0], x0[1]); w.y = cvtpk(x0[2], x0[3]); w.z = cvtpk(x0[4], x0[5]); w.w = cvtpk(x0[6], x0[7]); pk[0] = __builtin_bit_cast(bf16x8, w);
              w.x = cvtpk(x0[8], x0[9]); w.y = cvtpk(x0[10], x0[11]); w.z = cvtpk(x0[12], x0[13]); w.w = cvtpk(x0[14], x0[15]); pk[1] = __builtin_bit_cast(bf16x8, w);
              w.x = cvtpk(x1[0], x1[1]); w.y = cvtpk(x1[2], x1[3]); w.z = cvtpk(x1[4], x1[5]); w.w = cvtpk(x1[6], x1[7]); pk[2] = __builtin_bit_cast(bf16x8, w);
              w.x = cvtpk(x1[8], x1[9]); w.y = cvtpk(x1[10], x1[11]); w.z = cvtpk(x1[12], x1[13]); w.w = cvtpk(x1[14], x1[15]); pk[3] = __builtin_bit_cast(bf16x8, w); }
            __builtin_amdgcn_sched_barrier(0);
            if (!VPRE) {
#pragma unroll
                for (int s = 0; s < 4; ++s) { vl[s] = vtr(vb + (16 * s) * VSTR); vh[s] = vtr(vb + (16 * s + 8) * VSTR); }
                __builtin_amdgcn_sched_barrier(0);
            }
#pragma unroll
            for (int d = 0; d < ND; ++d) {
                s16x4 nl[4], nh[4];
                if (d + 1 < ND) {
#pragma unroll
                    for (int s = 0; s < 4; ++s) { nl[s] = vtr(vb + (16 * s) * VSTR + (d + 1) * 64); nh[s] = vtr(vb + (16 * s + 8) * VSTR + (d + 1) * 64); }
                    __builtin_amdgcn_sched_barrier(0);
                }
                __builtin_amdgcn_s_setprio(1);
#pragma unroll
                for (int s = 0; s < 4; ++s) {
                    const bf16x8 vf = (bf16x8){vl[s][0], vl[s][1], vl[s][2], vl[s][3], vh[s][0], vh[s][1], vh[s][2], vh[s][3]};
                    o[d] = __builtin_amdgcn_mfma_f32_32x32x16_bf16(vf, pk[s], o[d], 0, 0, 0);
                }
                __builtin_amdgcn_s_setprio(0);
                if (d + 1 < ND) {
#pragma unroll
                    for (int s = 0; s < 4; ++s) { vl[s] = nl[s]; vh[s] = nh[s]; }
                }
                __builtin_amdgcn_sched_barrier(0);
            }

}

template <int DQK, int DV, int KC1, int MASK, int ROPE, bool ALLT = false, int TR = 64>
DI void attn_unit(LAS unsigned char* lds, const AttnArgs& a, const int tid_in, u32x4 (&sk)[6], u32x4 (&sv)[6], const bool pre, const bool has_next, const AttnArgs& an) {
    int tid = tid_in; asm volatile("" : "+v"(tid));
    constexpr int KSTR = DQK * 2 + 16, VSTR = DV * 2 + 64;
    constexpr int KB = TR * KSTR, VB = TR * VSTR, BUF = KB + VB;
    constexpr int KCPR = DQK / 8, VCPR = DV / 8, KCH = TR * KCPR, VCH = TR * VCPR, NCH = KCH + VCH, NI = (NCH + 511) / 512;
    constexpr int NS = DQK / 16, ND = DV / 32;
    const int lane = tid & 63, wave = __builtin_amdgcn_readfirstlane(tid >> 6), l31 = lane & 31, half = lane >> 5;

    constexpr bool UNI = (KC1 == KCPR);
    const int gsu = 2 * TR * a.dil * a.k1pitch;
    const GAS char* gp[NI]; unsigned lo[NI]; int gst[UNI ? 1 : NI];
#define GST(i) (UNI ? gsu : gst[UNI ? 0 : (i)])
#pragma unroll
    for (int i = 0; i < NI; ++i) {
        int cid = tid + 512 * i; gp[i] = (const GAS char*)(a.K1 + (a.kvrow0 + (long)(a.tlo * 64) * a.dil) * a.k1pitch); lo[i] = 2 * BUF + (tid & 255) * 16; if (!UNI) gst[i] = 0;
        if (cid < KCH) { const int row = cid / KCPR, c = cid % KCPR; const long grow = a.kvrow0 + (long)(a.tlo * 64 + row) * a.dil;
            if (c < KC1) { gp[i] = (const GAS char*)(a.K1 + grow * a.k1pitch + c * 8); if (!UNI) gst[i] = 2 * TR * a.dil * a.k1pitch; }
            else { gp[i] = (const GAS char*)(a.K2 + grow * a.k2pitch + (c - KC1) * 8); if (!UNI) gst[i] = 2 * TR * a.dil * a.k2pitch; }
            lo[i] = row * KSTR + c * 16; }
        else if (cid < NCH) { cid -= KCH; const int row = cid / VCPR, c = cid % VCPR; const long grow = a.kvrow0 + (long)(a.tlo * 64 + row) * a.dil;
            gp[i] = (const GAS char*)(a.V + grow * a.vpitch + c * 8); if (!UNI) gst[i] = 2 * TR * a.dil * a.vpitch; lo[i] = KB + row * VSTR + c * 16; }
    }
    u32x4 sA[NI], sB[NI];
    constexpr int NTMAX = 6;
    const int ntile = a.thi - a.tlo;
    if (ALLT) {
        if (!pre) {
            const int row = tid >> 3, c = tid & 7; const long grow = a.kvrow0 + (long)(a.tlo * 64 + row) * a.dil;
            const GAS char* kp0 = (const GAS char*)(a.K1 + grow * a.k1pitch + c * 8); const GAS char* vp0 = (const GAS char*)(a.V + grow * a.vpitch + c * 8);
#pragma unroll
            for (int tt = 0; tt < NTMAX; ++tt) { const int ts = tt < ntile ? tt : ntile - 1; sk[tt] = *(const GAS u32x4*)(kp0 + ts * gsu); sv[tt] = *(const GAS u32x4*)(vp0 + ts * gsu); }
        }
    } else {
#pragma unroll
        for (int i = 0; i < NI; ++i) sA[i] = *(const GAS u32x4*)(gp[i]);
        if (TR == 64 && NI <= 3 && a.tlo + 1 < a.thi) {
#pragma unroll
            for (int i = 0; i < NI; ++i) sB[i] = *(const GAS u32x4*)(gp[i] + GST(i));
        }
    }
    const int qn = a.q0 + wave * 32 + l31; const long qrow = a.qrow0 + (long)qn * a.dil;
    bf16x8 qf[NS];
    {
        const GAS bf16_t* qp = a.Q + qrow * a.qpitch + 8 * half;
        float f[NS][8];
#pragma unroll
        for (int s = 0; s < NS; ++s) unpack8(*(const GAS u32x4*)(qp + 16 * s), f[s]);
        if (ROPE == 1 && a.rc != nullptr) {
#pragma unroll
            for (int s = 0; s < 2; ++s) {
                const GAS f32x4* cp = (const GAS f32x4*)(a.rc + qrow * 32 + 16 * s + 8 * half); const GAS f32x4* sp = (const GAS f32x4*)(a.rs + qrow * 32 + 16 * s + 8 * half);
                const f32x4 c0 = cp[0], c1 = cp[1], s0 = sp[0], s1 = sp[1];
#pragma unroll
                for (int j = 0; j < 8; ++j) { const float c = j < 4 ? c0[j & 3] : c1[j & 3], sn = j < 4 ? s0[j & 3] : s1[j & 3];
                    const float x1 = f[s][j], x2 = f[s + 2][j]; f[s][j] = x1 * c - x2 * sn; f[s + 2][j] = x2 * c + x1 * sn; }
            }
        } else if (ROPE == 2) {
            const GAS f32x4* cp = (const GAS f32x4*)(a.rc + qrow * 16 + 8 * half); const GAS f32x4* sp = (const GAS f32x4*)(a.rs + qrow * 16 + 8 * half);
            const f32x4 c0 = cp[0], c1 = cp[1], s0 = sp[0], s1 = sp[1];
#pragma unroll
            for (int j = 0; j < 8; ++j) { const float c = j < 4 ? c0[j & 3] : c1[j & 3], sn = j < 4 ? s0[j & 3] : s1[j & 3];
                const float x1 = f[NS - 2][j], x2 = f[NS - 1][j]; f[NS - 2][j] = x1 * c - x2 * sn; f[NS - 1][j] = x2 * c + x1 * sn; }
        }
#pragma unroll
        for (int s = 0; s < NS; ++s) {
#pragma unroll
            for (int j = 0; j < 8; ++j) f[s][j] *= a.scale2;
            qf[s] = pack8(f[s]);
        }
    }
    float m = a.sink2, l = (a.sink2 > -1e30f && half == 0) ? 1.f : 0.f;
    f32x16 negm;
#pragma unroll
    for (int r = 0; r < 16; ++r) negm[r] = 0.f;
    f32x16 o[ND];
#pragma unroll
    for (int d = 0; d < ND; ++d)
#pragma unroll
        for (int r = 0; r < 16; ++r) o[d][r] = 0.f;

    const int qw0 = a.q0 + wave * 32;
    int wlo = a.tlo, whi = a.thi;
    if (MASK >= 1) { const int e = (qw0 + 31) / 64 + 1; whi = e < whi ? e : whi; }
    if (MASK == 2) { const int s0 = qw0 - a.W; const int b = s0 > 0 ? s0 / 64 : 0; wlo = b > wlo ? b : wlo; }

    const LAS unsigned char* kfrag = lds + l31 * KSTR + half * 16;
    const LAS unsigned char* vfrag = lds + KB + (4 * half + ((lane & 15) >> 2)) * VSTR + ((lane >> 4) & 1) * 32 + (lane & 3) * 8;

    if constexpr (TR == 128) {
        __syncthreads();
#pragma unroll
        for (int i = 0; i < NI; ++i) *(LAS u32x4*)(lds + lo[i]) = sA[i];
        __syncthreads();
        for (int t = a.tlo; t < a.thi; t += 2) {
            const int cur = ((t - a.tlo) >> 1) & 1;
            if (t + 2 < a.thi) {
#pragma unroll
                for (int i = 0; i < NI; ++i) sA[i] = *(const GAS u32x4*)(gp[i] + ((t + 2 - a.tlo) >> 1) * GST(i));
            }
            if (t >= wlo && t < whi) attn_tile<DQK, DV, MASK>(kfrag + cur * BUF, vfrag + cur * BUF, qf, o, m, l, negm, t != wlo, t, qn, qw0, half, a.W);
            if (t + 1 >= wlo && t + 1 < whi) attn_tile<DQK, DV, MASK>(kfrag + cur * BUF + 64 * KSTR, vfrag + cur * BUF + 64 * VSTR, qf, o, m, l, negm, t + 1 != wlo, t + 1, qn, qw0, half, a.W);
            if (t + 2 < a.thi) {
#pragma unroll
                for (int i = 0; i < NI; ++i) *(LAS u32x4*)(lds + ((tid + 512 * i < NCH) ? (cur ^ 1) * BUF : 0) + lo[i]) = sA[i];
            }
            __syncthreads();
        }
    } else
    if (!ALLT) {
    if (NI > 3 && a.tlo + 1 < a.thi) {
#pragma unroll
        for (int i = 0; i < NI; ++i) sB[i] = *(const GAS u32x4*)(gp[i] + GST(i));
    }
    __syncthreads();
#pragma unroll
    for (int i = 0; i < NI; ++i) *(LAS u32x4*)(lds + lo[i]) = sA[i];
    __syncthreads();
#define ATT_ITER(PEND, NEW) { \
        const int cur = (t - a.tlo) & 1; \
        if (t + 2 < a.thi) { _Pragma("unroll") for (int i = 0; i < NI; ++i) NEW[i] = *(const GAS u32x4*)(gp[i] + (t + 2 - a.tlo) * GST(i)); } \
        if (t >= wlo && t < whi) attn_tile<DQK, DV, MASK>(kfrag + cur * BUF, vfrag + cur * BUF, qf, o, m, l, negm, t != wlo, t, qn, qw0, half, a.W); \
        if (t + 1 < a.thi) { _Pragma("unroll") for (int i = 0; i < NI; ++i) *(LAS u32x4*)(lds + ((tid + 512 * i < NCH) ? (cur ^ 1) * BUF : 0) + lo[i]) = PEND[i]; } \
        __syncthreads(); }
    for (int t = a.tlo;;) {
        ATT_ITER(sB, sA)
        if (++t >= a.thi) break;
        ATT_ITER(sA, sB)
        if (++t >= a.thi) break;
    }
#undef ATT_ITER
#undef GST
    } else {
        __syncthreads();
        { const int row = tid >> 3, c = tid & 7;
#pragma unroll
          for (int tt = 0; tt < (ALLT ? NTMAX : 1); ++tt) { *(LAS u32x4*)(lds + tt * BUF + row * KSTR + c * 16) = sk[tt]; *(LAS u32x4*)(lds + tt * BUF + KB + row * VSTR + c * 16) = sv[tt]; } }
        __syncthreads();
        if (has_next) {
            const int row = tid >> 3, c = tid & 7; const long grow = an.kvrow0 + (long)(an.tlo * 64 + row) * an.dil; const int nnt = an.thi - an.tlo, ngs = 128 * an.dil * an.k1pitch;
            const GAS char* kp0 = (const GAS char*)(an.K1 + grow * an.k1pitch + c * 8); const GAS char* vp0 = (const GAS char*)(an.V + grow * an.vpitch + c * 8);
#pragma unroll
            for (int tt = 0; tt < (ALLT ? NTMAX : 1); ++tt) { const int ts = tt < nnt ? tt : nnt - 1; sk[tt] = *(const GAS u32x4*)(kp0 + ts * ngs); sv[tt] = *(const GAS u32x4*)(vp0 + ts * ngs); }
        }
        for (int t = wlo; t < whi; ++t) attn_tile<DQK, DV, MASK>(kfrag + (t - a.tlo) * BUF, vfrag + (t - a.tlo) * BUF, qf, o, m, l, negm, t != wlo, t, qn, qw0, half, a.W);
        __syncthreads();
    }

    const float lt = l + __shfl_xor(l, 32);
    float wself = __builtin_amdgcn_rcpf(lt), wa = 0.f, wb = 0.f;
    if (a.omode == 1) { if (half == 0) a.lse_out[qrow * 16 + a.head] = m + __builtin_amdgcn_logf(lt); }
    if (a.omode == 2) {
        const float L3 = m + __builtin_amdgcn_logf(lt), La = a.lse_a[qrow * 16 + a.head], Lb = a.lse_b[qrow * 16 + a.head];
        const float M = fmaxf(L3, fmaxf(La, Lb));
        const float ea = __builtin_amdgcn_exp2f(La - M), eb = __builtin_amdgcn_exp2f(Lb - M), e3 = __builtin_amdgcn_exp2f(L3 - M);
        const float inv = __builtin_amdgcn_rcpf(ea + eb + e3);
        wa = ea * inv; wb = eb * inv; wself = e3 * inv * wself;
    }
    constexpr int OSTR = DV * 2 + 16, OST0 = ALLT ? 0 : 2 * BUF + 4096;
    LAS unsigned char* stg = lds + OST0 + wave * (32 * OSTR);
#pragma unroll
    for (int d = 0; d < ND; ++d)
#pragma unroll
        for (int g = 0; g < 4; ++g) {
            float v0 = o[d][4 * g] * wself, v1 = o[d][4 * g + 1] * wself, v2 = o[d][4 * g + 2] * wself, v3 = o[d][4 * g + 3] * wself;
            const int col = 32 * d + 8 * g;
            if (a.omode == 2) {
                const u32x2 pa = *(const GAS u32x2*)(a.Oa + qrow * a.opitch + 4 * half + col), pb = *(const GAS u32x2*)(a.Ob + qrow * a.opitch + 4 * half + col);
                v0 += wa * bflo(pa.x) + wb * bflo(pb.x); v1 += wa * bfhi(pa.x) + wb * bfhi(pb.x);
                v2 += wa * bflo(pa.y) + wb * bflo(pb.y); v3 += wa * bfhi(pa.y) + wb * bfhi(pb.y);
            }
            u32x2 w; w.x = cvtpk(v0, v1); w.y = cvtpk(v2, v3);
            *(LAS u32x2*)(stg + l31 * OSTR + (col + 4 * half) * 2) = w;
        }
    asm volatile("s_waitcnt lgkmcnt(0)" ::: "memory");
    {
        constexpr int CPR = DV / 8, RPI = 64 / CPR;
        const int rr = lane / CPR, ch = lane % CPR;
#pragma unroll
        for (int i = 0; i < 32 / RPI; ++i) {
            const int row = i * RPI + rr;
            const u32x4 v = *(const LAS u32x4*)(stg + row * OSTR + ch * 16);
            const long grow = a.qrow0 + (long)(a.q0 + wave * 32 + row) * a.dil;
            *(GAS u32x4*)(a.O + grow * a.opitch + ch * 8) = v;
        }
    }
}

DI AttnArgs band_args(int u, int layer, int dil, GAS bf16_t* BIG, GAS bf16_t* R1, GAS bf16_t* R2, GAS float* LSE1, GAS float* LSE2, const GAS float* R64C, const GAS float* R64S, const GAS float* sinks) {
    AttnArgs a{};
    a.rc = R64C; a.rs = R64S; a.scale2 = 0.125f * LOG2E;
    if (layer == 0) {
        const int qb = u & 31, h = (u >> 5) & 7, b = u >> 8, kvh = h >> 2;
        a.Q = BIG + h * 64; a.qpitch = ZP; a.K1 = BIG + Z_KA + kvh * 64; a.k1pitch = ZP; a.K2 = a.K1; a.k2pitch = ZP; a.V = BIG + Z_VA + kvh * 64; a.vpitch = ZP;
        a.O = R2 + h * 64; a.opitch = D; a.qrow0 = (long)b * S; a.kvrow0 = a.qrow0; a.dil = 1; a.q0 = qb * 256; a.W = 127;
        a.tlo = qb * 4 - 2 < 0 ? 0 : qb * 4 - 2; a.thi = qb * 4 + 4;
        a.sink2 = sinks[h] * LOG2E; a.omode = 0; a.head = h;
    } else {
        const int nblk = 32 / dil; const int nb = u % nblk, r = (u / nblk) % dil, h = (u >> 5) & 15, b = u >> 9;
        const size_t slab = ((size_t)b * 15 * S + (size_t)h * S) * 64;
        a.Q = BIG + slab; a.qpitch = 64; a.K1 = BIG + (size_t)T * 1024 + slab; a.k1pitch = 64; a.K2 = a.K1; a.k2pitch = 64; a.V = BIG + (size_t)T * 2048 + slab; a.vpitch = 64;
        a.opitch = D; a.qrow0 = (long)b * S + r; a.kvrow0 = a.qrow0; a.dil = dil; a.q0 = nb * 256; a.W = 128;
        a.tlo = nb * 4 - 2 < 0 ? 0 : nb * 4 - 2; a.thi = nb * 4 + 4;
        a.sink2 = -INFINITY; a.head = h; a.rc = nullptr; a.rs = nullptr; a.scale2 = 1.f;
        if (dil == 1) { a.omode = 1; a.O = R1 + h * 64; a.lse_out = LSE1; }
        else if (dil == 4) { a.omode = 1; a.O = R2 + h * 64; a.lse_out = LSE2; }
        else { a.omode = 2; a.O = R1 + h * 64; a.Oa = R1 + h * 64; a.Ob = R2 + h * 64; a.lse_a = LSE1; a.lse_b = LSE2; }
    }
    return a;
}

DI void wt_item(const GAS float* W, int ldw, int K, const GAS float* g, GAS bf16_t* Bt, int roff, int rbs, int ncols, int nblk, int item, LAS float* scr, int lane, int rp_lo = 0, int rp_hi = 0) {
    const int kb = item / nblk, nb = item % nblk, k0 = 64 * kb, c0 = 32 * nb;
    const int c = c0 + (lane & 31);
    float wv[32];
    const int cl = c < ncols ? c : ncols - 1;
#pragma unroll
    for (int i = 0; i < 32; ++i) wv[i] = W[(size_t)(k0 + 2 * i + (lane >> 5)) * ldw + cl];
    const float gsel = (c < ncols) ? 1.f : 0.f;
#pragma unroll
    for (int i = 0; i < 32; ++i) { const int kk = 2 * i + (lane >> 5); float v = wv[i] * gsel; if (g) v *= g[k0 + kk]; scr[kk * 33 + (lane & 31)] = v; }
    asm volatile("s_waitcnt lgkmcnt(0)" ::: "memory");
    const int cch = lane & 7;
#pragma unroll
    for (int j = 0; j < 4; ++j) { const int n = (lane >> 3) + 8 * j; const LAS float* s = scr + (8 * cch) * 33 + n;
        u32x4 o; o.x = cvtpk(s[0 * 33], s[1 * 33]); o.y = cvtpk(s[2 * 33], s[3 * 33]); o.z = cvtpk(s[4 * 33], s[5 * 33]); o.w = cvtpk(s[6 * 33], s[7 * 33]);
        const int cc = c0 + n; int drow = roff + (cc >> 7) * rbs + (cc & 127);
        if (cc >= rp_lo && cc < rp_hi) drow = roff + (cc & ~255) + 128 * ((cc >> 5) & 1) + 32 * ((cc >> 6) & 3) + (cc & 31);
        *(GAS u32x4*)(Bt + (size_t)drow * K + k0 + 8 * cch) = o; }
    asm volatile("s_waitcnt lgkmcnt(0)" ::: "memory");
}
DI void row_to_bf16(const GAS float* xrow, GAS bf16_t* orow, GAS float* ssq16, int lane) {
    const GAS f32x4* xr = (const GAS f32x4*)xrow + lane; f32x4 v[4]; float s = 0.f;
#pragma unroll
    for (int j = 0; j < 4; ++j) { v[j] = xr[64 * j]; s += (v[j][0] * v[j][0] + v[j][1] * v[j][1]) + (v[j][2] * v[j][2] + v[j][3] * v[j][3]); }
    s = wave_sum(s);
    GAS u32x2* o8 = (GAS u32x2*)orow + lane;
#pragma unroll
    for (int j = 0; j < 4; ++j) { u32x2 w; w.x = cvtpk(v[j][0], v[j][1]); w.y = cvtpk(v[j][2], v[j][3]); o8[64 * j] = w; }
    if (lane < 16) ssq16[lane] = lane == 0 ? s : 0.f;
}


#define XB_TMO      128
#define XB_XCNT(j)  (256  + 64 * (j))
#define XB_XSUB(j)  (1280 + 64 * (j))
#define XB_XGEN(j)  (2304 + 64 * (j))
#define XB_TOP      3328
#define XB_TOPGEN   3392
#define XCD_BAR_WORDS 3456
#define XB_SPIN_CAP (1u << 22)
DI unsigned xb_ld(unsigned* p)              { return __hip_atomic_load(p, __ATOMIC_RELAXED, __HIP_MEMORY_SCOPE_AGENT); }
DI unsigned xb_add(unsigned* p, unsigned v) { return __hip_atomic_fetch_add(p, v, __ATOMIC_RELAXED, __HIP_MEMORY_SCOPE_AGENT); }
DI unsigned xb_xcc_id() { return (unsigned)__builtin_amdgcn_s_getreg((3 << 11) | 20) & 0xFu; }
#define XB_SPIN(cond, bar) do { unsigned _sp = 0; while (cond) { __builtin_amdgcn_s_sleep(1); \
    if ((++_sp & 255u) == 0u) { if (xb_ld(&(bar)[XB_TMO])) break; if (_sp > XB_SPIN_CAP) { atomicAdd(&(bar)[XB_TMO], 1u); break; } } } } while (0)
struct XcdBarrier { unsigned* bar; unsigned x; volatile LAS unsigned* st; };
DI XcdBarrier xcd_barrier_post(unsigned* bar, volatile LAS unsigned* st) {
    XcdBarrier b; b.bar = bar; b.x = xb_xcc_id(); b.st = st;
    if (threadIdx.x == 0) (void)xb_add(&bar[XB_XCNT(b.x)], 1u);
    return b;
}
DI void xcd_barrier_complete(unsigned* bar, unsigned x, unsigned& nloc, unsigned& nx) {
    const unsigned G = gridDim.x * gridDim.y * gridDim.z;
    unsigned sum, cnt, mine, sp = 0u;
    for (;;) {
        sum = 0u; cnt = 0u; mine = 0u;
#pragma unroll
        for (unsigned j = 0; j < 16; ++j) { const unsigned c = xb_ld(&bar[XB_XCNT(j)]); sum += c; cnt += (c > 0u) ? 1u : 0u; mine = (j == x) ? c : mine; }
        if (sum == G) break;
        __builtin_amdgcn_s_sleep(1);
        if ((++sp & 255u) == 0u) { if (xb_ld(&bar[XB_TMO])) break; if (sp > XB_SPIN_CAP) { atomicAdd(&bar[XB_TMO], 1u); break; } }
    }
    nloc = mine > 0u ? mine : 1u; nx = cnt > 0u ? cnt : 1u;
}
DI void xcd_barrier(const XcdBarrier& b) {
    asm volatile("s_waitcnt vmcnt(0)" ::: "memory");
    __syncthreads();
    if (threadIdx.x == 0) {
        unsigned* bar = b.bar;
        __builtin_amdgcn_s_waitcnt(0);
        unsigned nloc = b.st[0], nx = b.st[1];
        if (nloc == 0u) { xcd_barrier_complete(bar, b.x, nloc, nx); b.st[0] = nloc; b.st[1] = nx; }
        const unsigned old = xb_add(&bar[XB_XSUB(b.x)], 1u);
        const unsigned gen = old / nloc;
        if (old + 1u == (gen + 1u) * nloc) {
            __builtin_amdgcn_fence(__ATOMIC_RELEASE, "agent");
            asm volatile("s_waitcnt vmcnt(0)" ::: "memory");
            const unsigned og = xb_add(&bar[XB_TOP], 1u);
            const unsigned tg = og / nx;
            if (og + 1u == (tg + 1u) * nx) xb_add(&bar[XB_TOPGEN], 1u);
            else XB_SPIN(xb_ld(&bar[XB_TOPGEN]) == tg, bar);
            __builtin_amdgcn_fence(__ATOMIC_ACQUIRE, "agent");
            xb_add(&bar[XB_XGEN(b.x)], 1u);
            asm volatile("s_waitcnt vmcnt(0)" ::: "memory");
        } else {
            XB_SPIN(xb_ld(&bar[XB_XGEN(b.x)]) == gen, bar);
            __builtin_amdgcn_fence(__ATOMIC_ACQUIRE, "agent");
            asm volatile("s_waitcnt vmcnt(0)" ::: "memory");
        }
    }
    __syncthreads();
}

#ifndef REPEAT_MASK
#define REPEAT_MASK 0u
#endif
struct Params { const void* in[33]; float* out; unsigned char* ws; int lo, hi; };

__global__ void __launch_bounds__(512, 2) fwd_kernel(Params P) {
    extern __shared__ __attribute__((aligned(16))) unsigned char lds_raw[];
    LAS unsigned char* lds = (LAS unsigned char*)lds_raw;
    cg::grid_group grid = cg::this_grid();
    const int wave0 = __builtin_amdgcn_readfirstlane(threadIdx.x >> 6);
    volatile LAS unsigned* bst = (volatile LAS unsigned*)(lds + 163840 - 64);
    if (threadIdx.x < 2) bst[threadIdx.x] = 0u;
    unsigned* barw = (unsigned*)P.ws;
    __syncthreads();
    if (P.hi < 0) grid.sync();
    XcdBarrier xbar = xcd_barrier_post(barw, bst);
    for (int st2 = 2 * P.lo; st2 < 2 * P.hi; ++st2) {
        const int st = st2 >> 1;
        if ((st2 & 1) && !((REPEAT_MASK >> st) & 1u)) continue;
        int zero; asm volatile("s_mov_b32 %0, 0" : "=s"(zero));
        int tid = wave0 * 64 + (int)__builtin_amdgcn_mbcnt_hi(~0u, __builtin_amdgcn_mbcnt_lo(~0u, 0u)); asm volatile("" : "+v"(tid));
        const int lane = tid & 63, wave = __builtin_amdgcn_readfirstlane(tid >> 6);
        GAS unsigned char* ws = (GAS unsigned char*)P.ws; asm volatile("" : "+s"(ws));
        int G = gridDim.x, bid = blockIdx.x; asm volatile("" : "+s"(G), "+s"(bid));
        const int gw = bid * 8 + wave, NGW = G * 8;
        const int vcu = (G == 256) ? (bid & 7) * 32 + (bid >> 3) : bid;
#define WSB(off) ((GAS bf16_t*)(ws + (off) * MiB))
#define WSF(off) ((GAS float*)(ws + (off) * MiB))
#define PIN(k) (P.in[(k) + zero])
        const GAS float* x_in = (const GAS float*)PIN(0); const GAS float* mem_in = (const GAS float*)PIN(1); const GAS int* pos_in = (const GAS int*)PIN(2);
        GAS float* X = (GAS float*)P.out; asm volatile("" : "+s"(X));
        GAS bf16_t* XB = WSB(O_XB); GAS bf16_t* BIG = WSB(O_BIG); GAS bf16_t* R1 = WSB(O_R1); GAS bf16_t* R2 = WSB(O_R2); GAS bf16_t* OB = WSB(O_OB);
        GAS bf16_t* QB = BIG + (size_t)T * ZP;
        GAS bf16_t* QX = R2; GAS bf16_t* OX = R2 + (size_t)T * 512;
        GAS bf16_t* MEMB = WSB(O_MEMB); GAS bf16_t* MEMKV = WSB(O_MEMKV);
        GAS float* SSQ = WSF(O_SSQ); GAS float* SSQQ = WSF(O_SSQQ); GAS float* SSQKV = WSF(O_SSQKV); GAS float* MEMSSQ = WSF(O_MEMSSQ);
        GAS float* R64C = WSF(O_R64C); GAS float* R64S = WSF(O_R64S); GAS float* R32C = WSF(O_R32C); GAS float* R32S = WSF(O_R32S);
        GAS float* LSE1 = WSF(O_LSE1); GAS float* LSE2 = WSF(O_LSE2);
        int kind = 0;
        bool sync_after = true;
        pg8::Gemm g{nullptr, nullptr, 0, 0, 0, 0}; pg8::EpiP e{nullptr, 0, nullptr, 0.f, nullptr, nullptr, nullptr, nullptr, nullptr, nullptr, nullptr, 0, 0};
        e.X16 = (GAS _Float16*)WSB(O_OB); int rmode = 1;
        int layer = 0, dil = 1;
        switch (st) {
        case 1: kind = 1; g = {XB, WSB(W_IN), T, ZP, D, D}; e.O = BIG; e.ldc = ZP; e.ssq = SSQ; e.inv_dim = 1.f / D; sync_after = false; break;
        case 2: kind = 1; g = {MEMB, WSB(W_XKV), MROWS, 2048, D, D}; e.O = MEMKV; e.ldc = 2048; e.ssq = MEMSSQ; e.inv_dim = 1.f / D; break;
        case 4: kind = 1; g = {BIG + Z_CQ, WSB(W_UQ), T, 768, 384, ZP}; e.O = QB; e.ldc = 768; e.ssq = SSQQ; e.inv_dim = 1.f / 384; sync_after = false; break;
        case 5: kind = 1; g = {BIG + Z_CKV, WSB(W_UKV), T, 1024, 256, ZP}; e.O = R1; e.ldc = 1024; e.ssq = SSQKV; e.inv_dim = 1.f / 256; sync_after = false; break;
        case 6: kind = 4; layer = 0; break;
        case 7: kind = 5; break;
        case 8: kind = 3; rmode = 0; g = {R2, WSB(W_OUT0), T, D, D, D}; e.Xin = x_in; e.Xout = X; e.XB = XB; e.ssq_out = SSQ; break;
        case 9: kind = 1; g = {XB, WSB(W_XQ0), T, 512, D, D}; e.O = QX; e.ldc = 512; e.ssq = SSQ; e.inv_dim = 1.f / D; break;
        case 10: kind = 6; layer = 0; break;
        case 11: kind = 3; g = {OX, WSB(W_XO0), T, D, 512, 512}; e.Xin = X; e.Xout = X; e.XB = XB; e.ssq_out = SSQ; break;
        case 12: kind = 2; g = {XB, WSB(W_GU0), T, 2 * FF, D, D}; e.O = BIG; e.ldc = FF; e.ssq = SSQ; e.inv_dim = 1.f / D; break;
        case 13: kind = 3; g = {BIG, WSB(W_DN0), T, D, FF, FF}; e.Xin = X; e.Xout = X; e.XB = XB; e.ssq_out = SSQ; break;
        case 14: kind = 7; g = {XB, WSB(W_QKV), T, 3072, D, D}; e.O = BIG; e.ldc = 3072; e.ssq = SSQ; e.inv_dim = 1.f / D; e.rc = R64C; e.rs = R64S; e.rope_lo = 0; e.rope_hi = 8; break;
        case 15: sync_after = false; break;
        case 16: kind = 4; layer = 1; dil = 1; sync_after = false; break;
        case 17: kind = 4; layer = 1; dil = 4; break;
        case 18: kind = 4; layer = 1; dil = 16; break;
        case 19: kind = 3; g = {R1, WSB(W_OUT1), T, D, D, D}; e.Xin = X; e.Xout = X; e.XB = XB; e.ssq_out = SSQ; break;
        case 20: kind = 1; g = {XB, WSB(W_XQ1), T, 512, D, D}; e.O = QX; e.ldc = 512; e.ssq = SSQ; e.inv_dim = 1.f / D; break;
        case 21: kind = 6; layer = 1; break;
        case 22: kind = 3; g = {OX, WSB(W_XO1), T, D, 512, 512}; e.Xin = X; e.Xout = X; e.XB = XB; e.ssq_out = SSQ; break;
        case 23: kind = 2; g = {XB, WSB(W_GU1), T, 2 * FF, D, D}; e.O = BIG; e.ldc = FF; e.ssq = SSQ; e.inv_dim = 1.f / D; break;
        case 24: kind = 3; rmode = 2; g = {BIG, WSB(W_DN1), T, D, FF, FF}; e.Xin = X; e.Xout = X; e.XB = XB; e.ssq_out = SSQ; break;
        default: break;
        }
        if ((kind >= 1 && kind <= 3) || kind == 7) {
            pg8::StaticOrder SO; SO.init(g.M, g.N, G, bid);
            if (kind == 7) { pg8::EpiScaleRope E{e}; pg8::gemm_phase(lds, g, SO, E, tid); }
            else if (kind == 1) { pg8::EpiScale E{e}; pg8::gemm_phase(lds, g, SO, E, tid); }
            else if (kind == 2) { pg8::EpiSwiglu E{e}; pg8::gemm_phase(lds, g, SO, E, tid); }
            else if (rmode == 0) { pg8::EpiResid<0> E{e}; pg8::gemm_phase(lds, g, SO, E, tid); }
            else if (rmode == 1) { pg8::EpiResid<1> E{e}; pg8::gemm_phase(lds, g, SO, E, tid); }
            else { pg8::EpiResid<2> E{e}; pg8::gemm_phase(lds, g, SO, E, tid); }
        } else if (kind == 4) {
            const int nunits = layer == 0 ? 2048 : 4096;
            u32x4 sk[6], sv[6]; bool pre = false;
#pragma unroll
            for (int i = 0; i < 6; ++i) { sk[i] = (u32x4){0u, 0u, 0u, 0u}; sv[i] = (u32x4){0u, 0u, 0u, 0u}; }
            for (int u = vcu; u < nunits; u += G) {
                const bool hn = (u + G < nunits);
                const AttnArgs a = band_args(u, layer, dil, BIG, R1, R2, LSE1, LSE2, R64C, R64S, (const GAS float*)PIN(5));
                const AttnArgs an = band_args(hn ? u + G : u, layer, dil, BIG, R1, R2, LSE1, LSE2, R64C, R64S, (const GAS float*)PIN(5));
                attn_unit<64, 64, 8, 2, 1, true>(lds, a, tid, sk, sv, pre, hn, an);
                pre = hn;
            }
        } else if (kind == 5) {
            for (int rr = 0; rr < 8; ++rr) {
                int qb, bh;
                if (G == 256) { const int xcd = bid & 7, j = bid >> 3; bh = xcd * 8 + rr; qb = (rr & 1) ? 31 - j : j; }
                else { const int i = rr * G + ((rr & 1) ? (G - 1 - bid) : bid); if (i >= 2048) break; qb = 31 - (i >> 6); bh = i & 63; }
                const int b = bh >> 3, h = bh & 7;
                AttnArgs a{};
                a.rc = R32C; a.rs = R32S; a.scale2 = 0.10206207261596577f * LOG2E;
                a.Q = QB + h * 96; a.qpitch = 768; a.K1 = R1 + h * 128; a.k1pitch = 1024; a.K2 = BIG + Z_KR; a.k2pitch = ZP; a.V = R1 + h * 128 + 64; a.vpitch = 1024;
                a.O = R2 + 512 + h * 64; a.opitch = D; a.qrow0 = (long)b * S; a.kvrow0 = a.qrow0; a.dil = 1; a.q0 = qb * 256; a.W = 0;
                a.tlo = 0; a.thi = qb * 4 + 4; a.sink2 = -INFINITY; a.omode = 0; a.head = h;
                { u32x4 dk[6] = {}, dv[6] = {}; attn_unit<96, 64, 8, 1, 2, false, 128>(lds, a, tid, dk, dv, false, false, a); }
            }
        } else if (kind == 6) {
            for (int u = vcu; u < 1024; u += G) {
                const int qb = u & 31, h = (u >> 5) & 3, b = u >> 7;
                AttnArgs a{};
                a.scale2 = 0.08838834764831845f * LOG2E;
                a.Q = QX + h * 128; a.qpitch = 512; a.K1 = MEMKV + layer * 1024 + h * 128; a.k1pitch = 2048; a.K2 = a.K1; a.k2pitch = 2048; a.V = MEMKV + layer * 1024 + 512 + h * 128; a.vpitch = 2048;
                a.O = OX + h * 128; a.opitch = 512; a.qrow0 = (long)b * S; a.kvrow0 = (long)b * MEMLEN; a.dil = 1; a.q0 = qb * 256; a.W = 0;
                a.tlo = 0; a.thi = 4; a.sink2 = -INFINITY; a.omode = 0; a.head = h;
                { u32x4 dk[6] = {}, dv[6] = {}; attn_unit<128, 128, 16, 0, 0>(lds, a, tid, dk, dv, false, false, a); }
            }
        } else if (st == 0) {
            LAS float* scr = (LAS float*)(lds + wave * 16384);
#define WJOB(W_, ldw_, K_, g_, Bt_, roff_, rbs_, ncols_, nphys_) { constexpr int cnt = ((K_) / 64) * ((nphys_) / 32); \
        if (r < cnt) { wt_item((const GAS float*)(W_), ldw_, K_, (const GAS float*)(g_), Bt_, roff_, rbs_, ncols_, (nphys_) / 32, r, scr, lane); continue; } r -= cnt; }
#define WJOBP(W_, ldw_, K_, g_, Bt_, roff_, rbs_, ncols_, nphys_, plo_, phi_) { constexpr int cnt = ((K_) / 64) * ((nphys_) / 32); \
        if (r < cnt) { wt_item((const GAS float*)(W_), ldw_, K_, (const GAS float*)(g_), Bt_, roff_, rbs_, ncols_, (nphys_) / 32, r, scr, lane, plo_, phi_); continue; } r -= cnt; }
            constexpr int NITEMS = (1024 / 64) * (1536 / 32) + (384 / 64) * (768 / 32) + (256 / 64) * (1024 / 32) + 16 * 32 + 16 * 16 + 16 * 32 + 8 * 32 + 2 * 16 * 88 + 44 * 32
                                 + 16 * 96 + 16 * 32 + 16 * 16 + 16 * 32 + 8 * 32 + 2 * 16 * 88 + 44 * 32;
            for (int it = gw; it < NITEMS; it += NGW) {
                int r = it;
                WJOB(PIN(4), 1440, 1024, PIN(3), WSB(W_IN), 0, 128, 1440, 1536)
                WJOB(PIN(7), 768, 384, PIN(6), WSB(W_UQ), 0, 128, 768, 768)
                WJOB(PIN(9), 1024, 256, PIN(8), WSB(W_UKV), 0, 128, 1024, 1024)
                WJOB(PIN(10), 1024, 1024, nullptr, WSB(W_OUT0), 0, 128, 1024, 1024)
                WJOB(PIN(13), 512, 1024, PIN(11), WSB(W_XQ0), 0, 128, 512, 512)
                WJOB(PIN(14), 1024, 1024, PIN(12), WSB(W_XKV), 0, 128, 1024, 1024)
                WJOB(PIN(15), 1024, 512, nullptr, WSB(W_XO0), 0, 128, 1024, 1024)
                WJOB(PIN(17), FF, 1024, PIN(16), WSB(W_GU0), 0, 256, FF, FF)
                WJOB(PIN(18), FF, 1024, PIN(16), WSB(W_GU0), 128, 256, FF, FF)
                WJOB(PIN(19), 1024, FF, nullptr, WSB(W_DN0), 0, 128, 1024, 1024)
                WJOBP(PIN(21), 3072, 1024, PIN(20), WSB(W_QKV), 0, 128, 3072, 3072, 0, 2048)
                WJOB(PIN(22), 1024, 1024, nullptr, WSB(W_OUT1), 0, 128, 1024, 1024)
                WJOB(PIN(25), 512, 1024, PIN(23), WSB(W_XQ1), 0, 128, 512, 512)
                WJOB(PIN(26), 1024, 1024, PIN(24), WSB(W_XKV), 1024, 128, 1024, 1024)
                WJOB(PIN(27), 1024, 512, nullptr, WSB(W_XO1), 0, 128, 1024, 1024)
                WJOB(PIN(29), FF, 1024, PIN(28), WSB(W_GU1), 0, 256, FF, FF)
                WJOB(PIN(30), FF, 1024, PIN(28), WSB(W_GU1), 128, 256, FF, FF)
                WJOB(PIN(31), 1024, FF, nullptr, WSB(W_DN1), 0, 128, 1024, 1024)
            }
#undef WJOB
#undef WJOBP
            for (int idx = bid * 512 + tid; idx < T * 32; idx += G * 512) {
                const int t = idx >> 5, i = idx & 31;
                const float invf = exp2f(-(float)i * (13.287712379549449f / 32.0f));
                const float af = (float)pos_in[t] * invf;
                float s, c; sincosf(af, &s, &c);
                R64C[idx] = c; R64S[idx] = s;
                if (!(i & 1)) { R32C[t * 16 + (i >> 1)] = c; R32S[t * 16 + (i >> 1)] = s; }
            }
            for (int m0 = gw; m0 < T; m0 += 4 * NGW) {
                f32x4 v[4][4];
#pragma unroll
                for (int r = 0; r < 4; ++r)
#pragma unroll
                    for (int j = 0; j < 4; ++j) v[r][j] = *((const GAS f32x4*)(x_in + (size_t)(m0 + r * NGW) * D) + lane + 64 * j);
#pragma unroll
                for (int r = 0; r < 4; ++r) { const int m = m0 + r * NGW; float s = 0.f;
#pragma unroll
                    for (int j = 0; j < 4; ++j) s += (v[r][j][0] * v[r][j][0] + v[r][j][1] * v[r][j][1]) + (v[r][j][2] * v[r][j][2] + v[r][j][3] * v[r][j][3]);
                    s = wave_sum(s);
                    GAS u32x2* o8 = (GAS u32x2*)(XB + (size_t)m * D) + lane;
#pragma unroll
                    for (int j = 0; j < 4; ++j) { u32x2 w; w.x = cvtpk(v[r][j][0], v[r][j][1]); w.y = cvtpk(v[r][j][2], v[r][j][3]); o8[64 * j] = w; }
                    if (lane < 16) SSQ[(size_t)m * 16 + lane] = lane == 0 ? s : 0.f; }
            }
            for (int m = gw; m < MROWS; m += NGW) row_to_bf16(mem_in + (size_t)m * D, MEMB + (size_t)m * D, MEMSSQ + (size_t)m * 16, lane);
        } else if (st == 3) {
            for (int t0 = gw; t0 < T; t0 += 4 * NGW) {
                u32x4 vq[4], vk[4], a1[4], a2[4]; f32x4 c0[4], c1[4], s0[4], s1[4];
                const int role = lane < 8 ? 0 : (lane < 10 ? 1 : 2);
                const int hd = (lane >> 2) & 1, q = lane & 3, q2 = lane & 1;
#pragma unroll
                for (int r = 0; r < 4; ++r) { const int t = t0 + r * NGW; GAS bf16_t* zr = BIG + (size_t)t * ZP;
                    vq[r] = *(const GAS u32x4*)(zr + Z_CQ + 8 * (lane < 48 ? lane : 0));
                    vk[r] = *(const GAS u32x4*)(zr + Z_CKV + 8 * (lane & 31));
                    const GAS bf16_t* p1 = role == 1 ? zr + Z_KR + 8 * q2 : zr + Z_KA + hd * 64 + 8 * q;
                    a1[r] = *(const GAS u32x4*)p1; a2[r] = *(const GAS u32x4*)(p1 + (role == 1 ? 16 : 32));
                    const GAS float* cb = role == 1 ? R32C + (size_t)t * 16 + 8 * q2 : R64C + (size_t)t * 32 + 8 * q;
                    const GAS float* sb = role == 1 ? R32S + (size_t)t * 16 + 8 * q2 : R64S + (size_t)t * 32 + 8 * q;
                    c0[r] = *(const GAS f32x4*)cb; c1[r] = *(const GAS f32x4*)(cb + 4); s0[r] = *(const GAS f32x4*)sb; s1[r] = *(const GAS f32x4*)(sb + 4); }
#pragma unroll
                for (int r = 0; r < 4; ++r) { const int t = t0 + r * NGW; GAS bf16_t* zr = BIG + (size_t)t * ZP;
                    float f[8]; unpack8(vq[r], f); float sq = 0.f;
#pragma unroll
                    for (int j = 0; j < 8; ++j) sq += f[j] * f[j];
                    sq = lane < 48 ? sq : 0.f;
                    unpack8(vk[r], f); float sk = 0.f;
#pragma unroll
                    for (int j = 0; j < 8; ++j) sk += f[j] * f[j];
                    sk = lane < 32 ? sk : 0.f;
                    sq = wave_sum(sq); sk = wave_sum(sk);
                    if (lane < 16) { SSQQ[(size_t)t * 16 + lane] = lane == 0 ? sq : 0.f; SSQKV[(size_t)t * 16 + lane] = lane == 0 ? sk : 0.f; }
                    if (role < 2) {
                        float x1[8], x2[8], y1[8], y2[8]; unpack8(a1[r], x1); unpack8(a2[r], x2);
#pragma unroll
                        for (int j = 0; j < 8; ++j) { const float c = j < 4 ? c0[r][j & 3] : c1[r][j & 3], s = j < 4 ? s0[r][j & 3] : s1[r][j & 3]; y1[j] = x1[j] * c - x2[j] * s; y2[j] = x2[j] * c + x1[j] * s; }
                        GAS bf16_t* p1 = role == 1 ? zr + Z_KR + 8 * q2 : zr + Z_KA + hd * 64 + 8 * q;
                        *(GAS bf16x8*)p1 = pack8(y1); *(GAS bf16x8*)(p1 + (role == 1 ? 16 : 32)) = pack8(y2);
                    }
                }
            }
        } else if (st == 25) {
            const GAS float* gfin = (const GAS float*)PIN(32);
            const GAS _Float16* X16 = (const GAS _Float16*)WSB(O_OB);
            typedef _Float16 f16x8 __attribute__((ext_vector_type(8)));
            f32x4 gv[2][2];
#pragma unroll
            for (int j = 0; j < 2; ++j) { gv[j][0] = *(const GAS f32x4*)(gfin + j * 512 + 8 * lane); gv[j][1] = *(const GAS f32x4*)(gfin + j * 512 + 8 * lane + 4); }
            for (int t0 = gw; t0 < T; t0 += 4 * NGW) {
                f16x8 h[4][2]; f32x4 pr[4][4];
#pragma unroll
                for (int r = 0; r < 4; ++r) { const int t = t0 + r * NGW;
#pragma unroll
                    for (int j = 0; j < 2; ++j) h[r][j] = *(const GAS f16x8*)(X16 + (size_t)t * D + j * 512 + 8 * lane);
#pragma unroll
                    for (int j = 0; j < 4; ++j) pr[r][j] = *(const GAS f32x4*)(SSQ + (size_t)t * 16 + 4 * j); }
#pragma unroll
                for (int r = 0; r < 4; ++r) { const int t = t0 + r * NGW;
                    float s = 0.f;
#pragma unroll
                    for (int j = 0; j < 4; ++j) s += (pr[r][j][0] + pr[r][j][1]) + (pr[r][j][2] + pr[r][j][3]);
                    const float rs = __builtin_amdgcn_rsqf(s * (1.f / D) + EPS);
#pragma unroll
                    for (int j = 0; j < 2; ++j) {
                        const f32x4 v0 = (f32x4){(float)h[r][j][0], (float)h[r][j][1], (float)h[r][j][2], (float)h[r][j][3]} * rs * gv[j][0];
                        const f32x4 v1 = (f32x4){(float)h[r][j][4], (float)h[r][j][5], (float)h[r][j][6], (float)h[r][j][7]} * rs * gv[j][1];
                        GAS float* op = X + (size_t)t * D + j * 512 + 8 * lane;
                        *(GAS f32x4*)op = v0; *(GAS f32x4*)(op + 4) = v1; }
                }
            }
        }
        if ((sync_after || (REPEAT_MASK >> st) & 1u) && st + 1 < P.hi) {
            xcd_barrier(xbar);
        }
    }
}

constexpr int LDS_BYTES = 163840;
constexpr int NSTEPS = 26;

extern "C" void kernel_launch(void* const* d_in, const int* in_sizes, int n_in, void* d_out, int out_size, void* d_ws, size_t ws_size, hipStream_t stream) {
    static int grid_blocks = 0;
    if (!grid_blocks) {
        if (n_in != 33 || out_size != T * D || ws_size < WS_NEED * MiB) { fprintf(stderr, "kernel_launch: unexpected shapes n_in=%d out=%d ws=%zu\n", n_in, out_size, ws_size); grid_blocks = -1; return; }
        int dev = 0, cus = 0, per_cu = 0;
        hipGetDevice(&dev);
        hipDeviceGetAttribute(&cus, hipDeviceAttributeMultiprocessorCount, dev);
        hipFuncSetAttribute((const void*)fwd_kernel, hipFuncAttributeMaxDynamicSharedMemorySize, LDS_BYTES);
        hipOccupancyMaxActiveBlocksPerMultiprocessor(&per_cu, (const void*)fwd_kernel, 512, LDS_BYTES);
        if (per_cu < 1) per_cu = 1;
        grid_blocks = cus * per_cu;
        (void)hipGetLastError();
    }
    if (grid_blocks < 0) return;
    Params p{};
    for (int i = 0; i < 33; ++i) p.in[i] = d_in[i];
    p.out = (float*)d_out; p.ws = (unsigned char*)d_ws; p.lo = 0; p.hi = NSTEPS;
    (void)hipMemsetAsync(d_ws, 0, 16384, stream);
    void* args[] = {&p};
    hipError_t e = hipLaunchCooperativeKernel((const void*)fwd_kernel, dim3(grid_blocks), dim3(512), args, LDS_BYTES, stream);
    if (e != hipSuccess) fprintf(stderr, "cooperative launch failed: %s (grid %d)\n", hipGetErrorString(e), grid_blocks);
}
```

```cpp
#include <hip/hip_runtime.h>
#include <hip/hip_cooperative_groups.h>
#include <cstdio>
#include <cstdint>
#include <cmath>
namespace cg = cooperative_groups;

#define LAS __attribute__((address_space(3)))
#define GAS __attribute__((address_space(1)))
#define DI __device__ __forceinline__
typedef unsigned short bf16_t;
typedef short bf16x8 __attribute__((ext_vector_type(8)));
typedef short s16x4 __attribute__((ext_vector_type(4)));
typedef float f32x2 __attribute__((ext_vector_type(2)));
typedef float f32x4 __attribute__((ext_vector_type(4)));
typedef float f32x16 __attribute__((ext_vector_type(16)));
typedef unsigned u32x2 __attribute__((ext_vector_type(2)));
typedef unsigned u32x4 __attribute__((ext_vector_type(4)));
typedef __bf16 bf16x2_t __attribute__((ext_vector_type(2)));

constexpr int NB = 8, S = 8192, T = NB * S, D = 1024, MEMLEN = 256, MROWS = NB * MEMLEN;
constexpr int ZP = 1536;
constexpr int Z_KA = 512, Z_VA = 640, Z_CQ = 768, Z_CKV = 1152, Z_KR = 1408;
constexpr int FF = 2816;
constexpr float EPS = 1e-6f;
constexpr float LOG2E = 1.4426950408889634f;

constexpr size_t MiB = 1u << 20;
constexpr size_t W_IN = 1, W_UQ = 4, W_UKV = 5, W_OUT0 = 6, W_XQ0 = 8, W_XKV = 9, W_XO0 = 13, W_GU0 = 14, W_DN0 = 25,
                 W_QKV = 31, W_OUT1 = 37, W_XQ1 = 39, W_XO1 = 40, W_GU1 = 41, W_DN1 = 52,
                 O_R64C = 58, O_R64S = 66, O_R32C = 74, O_R32S = 78, O_SSQ = 82, O_SSQQ = 86, O_SSQKV = 90, O_MEMSSQ = 94,
                 O_MEMB = 95, O_MEMKV = 99, O_LSE1 = 107, O_LSE2 = 111, O_XB = 116, O_BIG = 244, O_R1 = 628, O_R2 = 756, O_OB = 884,
                 WS_NEED = 1012;

DI unsigned cvtpk(float lo, float hi) { f32x2 v = {lo, hi}; bf16x2_t b = __builtin_convertvector(v, bf16x2_t); return __builtin_bit_cast(unsigned, b); }
DI float bflo(unsigned u) { return __uint_as_float(u << 16); }
DI float bfhi(unsigned u) { return __uint_as_float(u & 0xffff0000u); }
DI float bf2f(bf16_t h) { return __uint_as_float(((unsigned)h) << 16); }
DI bf16_t f2bf(float f) { return (bf16_t)(cvtpk(f, 0.f) & 0xffffu); }
DI float wave_sum(float v) {
#pragma unroll
    for (int o = 1; o < 64; o <<= 1) v += __shfl_xor(v, o);
    return v;
}

namespace pg8 {
constexpr int BM = 256, BK = 64, HALF = 128, HTB = HALF * BK * 2, NXCD = 8, WGM = 8;
DI int lds_byte(int r, int c) { const int st = (r >> 4) * 2 + (c >> 5), rr = r & 15, cc = c & 31, ob = rr * 64 + cc * 2; return st * 1024 + (ob ^ (((ob >> 9) & 1) << 5)); }
DI void stage_rc(int b, int& R, int& C) { const int st = b / 1024, sb = b % 1024, swz = sb ^ (((sb >> 9) & 1) << 5); R = (st >> 1) * 16 + swz / 64; C = (st & 1) * 32 + (swz % 64) / 2; }
DI int perm32(int rho) { const int n = rho >> 4, i = rho & 15; return 8 * (i >> 2) + 4 * n + (i & 3); }
struct Unit { int pm, pn; };
struct Gemm { const GAS bf16_t* A; const GAS bf16_t* Bt; int M, N, K, lda; };
struct StaticOrder {
    int nM, nN, nwg, G, c;
    DI void init(int M, int N, int G_, int c_) { nM = M / BM; nN = N / BM; nwg = nM * nN; G = G_; c = c_; }
    DI bool next(int i, Unit& u) const {
        const long L = (long)i * G + c; if (L >= nwg) return false;
        int wgid = (int)L; { const int q = nwg / NXCD, r = nwg % NXCD, xcd = wgid % NXCD, off = wgid / NXCD; wgid = (xcd < r ? xcd * (q + 1) : r * (q + 1) + (xcd - r) * q) + off; }
        const int nig = WGM * nN, gid = wgid / nig, fm = gid * WGM, gsz = (nM - fm) < WGM ? (nM - fm) : WGM;
        u.pm = fm + ((wgid % nig) % gsz); u.pn = (wgid % nig) / gsz; return true;
    }
};

typedef _Float16 f16x4 __attribute__((ext_vector_type(4)));
struct EpiP { GAS bf16_t* O; int ldc; const GAS float* ssq; float inv_dim; const GAS float* Xin; GAS float* Xout; GAS bf16_t* XB; GAS float* ssq_out; GAS _Float16* X16; const GAS float* rc; const GAS float* rs; int rope_lo, rope_hi; };

DI float row_rstd(const GAS float* ssq, float inv_dim, int row) {
    const GAS f32x4* p = (const GAS f32x4*)(ssq + (size_t)row * 16);
    const f32x4 a = p[0], b = p[1], c = p[2], d = p[3];
    const float s = ((a[0] + a[1]) + (a[2] + a[3])) + ((b[0] + b[1]) + (b[2] + b[3])) + ((c[0] + c[1]) + (c[2] + c[3])) + ((d[0] + d[1]) + (d[2] + d[3]));
    return __builtin_amdgcn_rsqf(s * inv_dim + EPS);
}
DI void rows_rstd(const GAS float* ssq, float inv_dim, int row0, int fq, float (&rs)[2][4]) {
    f32x4 pr[2][4];
#pragma unroll
    for (int ai = 0; ai < 2; ++ai)
#pragma unroll
        for (int m = 0; m < 4; ++m) pr[ai][m] = *(const GAS f32x4*)(ssq + (size_t)(row0 + ai * HALF + m * 16) * 16 + 4 * fq);
#pragma unroll
    for (int ai = 0; ai < 2; ++ai)
#pragma unroll
        for (int m = 0; m < 4; ++m) { float s = (pr[ai][m][0] + pr[ai][m][1]) + (pr[ai][m][2] + pr[ai][m][3]); s += __shfl_xor(s, 16); s += __shfl_xor(s, 32); rs[ai][m] = __builtin_amdgcn_rsqf(s * inv_dim + EPS); }
}
struct EpiScale {
    static constexpr bool PERM = true, RSTD = true; EpiP p;
    DI void operator()(const f32x4 (&acc)[2][2][4][2], const Unit& u, int wr, int wc, int fr, int fq, const LAS float* rl) const {
        const int row0 = u.pm * BM + wr * 64 + fr, col0 = u.pn * BM + wc * 32 + 8 * fq;
        float rs[2][4];
#pragma unroll
        for (int ai = 0; ai < 2; ++ai)
#pragma unroll
            for (int m = 0; m < 4; ++m) rs[ai][m] = rl[ai * HALF + wr * 64 + m * 16 + fr];
#pragma unroll
        for (int ai = 0; ai < 2; ++ai)
#pragma unroll
            for (int m = 0; m < 4; ++m) {
                const int row = row0 + ai * HALF + m * 16; const float r = rs[ai][m];
                GAS bf16_t* rowp = p.O + (size_t)row * p.ldc + col0;
#pragma unroll
                for (int bj = 0; bj < 2; ++bj) { const f32x4 v0 = acc[ai][bj][m][0] * r, v1 = acc[ai][bj][m][1] * r;
                    u32x4 w; w.x = cvtpk(v0[0], v0[1]); w.y = cvtpk(v0[2], v0[3]); w.z = cvtpk(v1[0], v1[1]); w.w = cvtpk(v1[2], v1[3]);
                    *(GAS u32x4*)(rowp + bj * HALF) = w; }
            }
    }
};
struct EpiScaleRope {
    static constexpr bool PERM = true, RSTD = true; EpiP p;
    DI size_t hm(int row, int sec, int h) const { return ((size_t)sec * T * 16 + (size_t)(row >> 13) * (16 * S) + (size_t)h * S + (row & (S - 1))) * 64; }
    DI void operator()(const f32x4 (&acc)[2][2][4][2], const Unit& u, int wr, int wc, int fr, int fq, const LAS float* rl) const {
        const int row0 = u.pm * BM + wr * 64 + fr;
        float rs[2][4];
#pragma unroll
        for (int ai = 0; ai < 2; ++ai)
#pragma unroll
            for (int m = 0; m < 4; ++m) rs[ai][m] = rl[ai * HALF + wr * 64 + m * 16 + fr];
        const int sec = u.pn >> 2;
        if (u.pn >= p.rope_lo && u.pn < p.rope_hi) {
            const int h = 4 * (u.pn & 3) + wc;
            const float qs = (sec == 0) ? 0.125f * LOG2E : 1.f;
#pragma unroll
            for (int g2 = 0; g2 < 4; ++g2) {
                f32x4 cv[2][2], sv[2][2];
#pragma unroll
                for (int mm = 0; mm < 2; ++mm) { const int ai = g2 >> 1, m = (g2 & 1) * 2 + mm; const size_t tb = (size_t)(row0 + ai * HALF + m * 16) * 32 + 8 * fq;
                    cv[mm][0] = *(const GAS f32x4*)(p.rc + tb); cv[mm][1] = *(const GAS f32x4*)(p.rc + tb + 4); sv[mm][0] = *(const GAS f32x4*)(p.rs + tb); sv[mm][1] = *(const GAS f32x4*)(p.rs + tb + 4); }
                __builtin_amdgcn_sched_barrier(0);
#pragma unroll
                for (int mm = 0; mm < 2; ++mm) { const int ai = g2 >> 1, m = (g2 & 1) * 2 + mm;
                    const int row = row0 + ai * HALF + m * 16; const float r = rs[ai][m] * qs;
                    const f32x4 a0 = acc[ai][0][m][0] * r, a1 = acc[ai][0][m][1] * r, b0 = acc[ai][1][m][0] * r, b1 = acc[ai][1][m][1] * r;
                    const f32x4 l0 = a0 * cv[mm][0] - b0 * sv[mm][0], l1 = a1 * cv[mm][1] - b1 * sv[mm][1];
                    const f32x4 h0 = b0 * cv[mm][0] + a0 * sv[mm][0], h1 = b1 * cv[mm][1] + a1 * sv[mm][1];
                    GAS bf16_t* rowp = p.O + hm(row, sec, h) + 8 * fq;
                    u32x4 w; w.x = cvtpk(l0[0], l0[1]); w.y = cvtpk(l0[2], l0[3]); w.z = cvtpk(l1[0], l1[1]); w.w = cvtpk(l1[2], l1[3]); *(GAS u32x4*)rowp = w;
                    w.x = cvtpk(h0[0], h0[1]); w.y = cvtpk(h0[2], h0[3]); w.z = cvtpk(h1[0], h1[1]); w.w = cvtpk(h1[2], h1[3]); *(GAS u32x4*)(rowp + 32) = w;
                }
            }
        } else {
#pragma unroll
            for (int ai = 0; ai < 2; ++ai)
#pragma unroll
                for (int m = 0; m < 4; ++m) {
                    const int row = row0 + ai * HALF + m * 16; const float r = rs[ai][m];
#pragma unroll
                    for (int bj = 0; bj < 2; ++bj) { const f32x4 v0 = acc[ai][bj][m][0] * r, v1 = acc[ai][bj][m][1] * r;
                        u32x4 w; w.x = cvtpk(v0[0], v0[1]); w.y = cvtpk(v0[2], v0[3]); w.z = cvtpk(v1[0], v1[1]); w.w = cvtpk(v1[2], v1[3]);
                        const int h = 4 * (u.pn & 3) + 2 * bj + (wc >> 1);
                        *(GAS u32x4*)(p.O + hm(row, sec, h) + 32 * (wc & 1) + 8 * fq) = w; }
                }
        }
    }
};
DI float silu_mul(float g, float u) { return g * __builtin_amdgcn_rcpf(1.f + __builtin_amdgcn_exp2f(-g * LOG2E)) * u; }
struct EpiSwiglu {
    static constexpr bool PERM = true, RSTD = true; EpiP p;
    DI void operator()(const f32x4 (&acc)[2][2][4][2], const Unit& u, int wr, int wc, int fr, int fq, const LAS float* rl) const {
        const int row0 = u.pm * BM + wr * 64 + fr, col0 = u.pn * HALF + wc * 32 + 8 * fq;
        float rs[2][4];
#pragma unroll
        for (int ai = 0; ai < 2; ++ai)
#pragma unroll
            for (int m = 0; m < 4; ++m) rs[ai][m] = rl[ai * HALF + wr * 64 + m * 16 + fr];
#pragma unroll
        for (int ai = 0; ai < 2; ++ai)
#pragma unroll
            for (int m = 0; m < 4; ++m) {
                const int row = row0 + ai * HALF + m * 16; const float r = rs[ai][m];
                const f32x4 g0 = acc[ai][0][m][0] * r, g1 = acc[ai][0][m][1] * r, u0 = acc[ai][1][m][0] * r, u1 = acc[ai][1][m][1] * r;
                u32x4 w; w.x = cvtpk(silu_mul(g0[0], u0[0]), silu_mul(g0[1], u0[1])); w.y = cvtpk(silu_mul(g0[2], u0[2]), silu_mul(g0[3], u0[3]));
                w.z = cvtpk(silu_mul(g1[0], u1[0]), silu_mul(g1[1], u1[1])); w.w = cvtpk(silu_mul(g1[2], u1[2]), silu_mul(g1[3], u1[3]));
                *(GAS u32x4*)(p.O + (size_t)row * p.ldc + col0) = w;
            }
    }
};
template <int MODE>
struct EpiResid {
    static constexpr bool PERM = true, RSTD = false; EpiP p;
    DI void operator()(const f32x4 (&acc)[2][2][4][2], const Unit& u, int wr, int wc, int fr, int fq, const LAS float* rl) const {
        typedef _Float16 f16x8 __attribute__((ext_vector_type(8)));
        const int row0 = u.pm * BM + wr * 64 + fr, col0 = u.pn * BM + wc * 32 + 8 * fq;
#pragma unroll
        for (int ai = 0; ai < 2; ++ai) {
            f32x4 xin[4][2][2];
#pragma unroll
            for (int m = 0; m < 4; ++m)
#pragma unroll
                for (int bj = 0; bj < 2; ++bj) { const size_t o2 = (size_t)(row0 + ai * HALF + m * 16) * D + col0 + bj * HALF;
                    if (MODE == 0) { xin[m][bj][0] = *(const GAS f32x4*)(p.Xin + o2); xin[m][bj][1] = *(const GAS f32x4*)(p.Xin + o2 + 4); }
                    else { const f16x8 h = *(const GAS f16x8*)(p.X16 + o2); xin[m][bj][0] = (f32x4){(float)h[0], (float)h[1], (float)h[2], (float)h[3]}; xin[m][bj][1] = (f32x4){(float)h[4], (float)h[5], (float)h[6], (float)h[7]}; } }
            __builtin_amdgcn_sched_barrier(0);
#pragma unroll
            for (int m = 0; m < 4; ++m) {
                const int row = row0 + ai * HALF + m * 16; const size_t off = (size_t)row * D + col0; float ss = 0.f;
#pragma unroll
                for (int bj = 0; bj < 2; ++bj) { const size_t o2 = off + bj * HALF;
                    const f32x4 v0 = xin[m][bj][0] + acc[ai][bj][m][0], v1 = xin[m][bj][1] + acc[ai][bj][m][1];
                    { const f16x8 h = {(_Float16)v0[0], (_Float16)v0[1], (_Float16)v0[2], (_Float16)v0[3], (_Float16)v1[0], (_Float16)v1[1], (_Float16)v1[2], (_Float16)v1[3]}; *(GAS f16x8*)(p.X16 + o2) = h; }
                    if (MODE != 2) { u32x4 w; w.x = cvtpk(v0[0], v0[1]); w.y = cvtpk(v0[2], v0[3]); w.z = cvtpk(v1[0], v1[1]); w.w = cvtpk(v1[2], v1[3]); *(GAS u32x4*)(p.XB + o2) = w; }
                    ss += ((v0[0] * v0[0] + v0[1] * v0[1]) + (v0[2] * v0[2] + v0[3] * v0[3])) + ((v1[0] * v1[0] + v1[1] * v1[1]) + (v1[2] * v1[2] + v1[3] * v1[3])); }
                ss += __shfl_xor(ss, 16); ss += __shfl_xor(ss, 32);
                if (fq == 0) p.ssq_out[(size_t)row * 16 + u.pn * 4 + wc] = ss;
            }
        }
    }
};

template <class Epi>
DI void gemm_phase(LAS unsigned char* lds, const Gemm g, const StaticOrder& S, const Epi& E, const int tid) {
    const int wid = __builtin_amdgcn_readfirstlane(tid >> 6), lane = tid & 63, wr = wid >> 2, wc = wid & 3, fr = lane & 15, fq = lane >> 4;
    const int K = g.K, nt = K / BK, lda = g.lda;
    unsigned voffA[2], voffB[2];
#pragma unroll
    for (int i = 0; i < 2; ++i) { int R, C; stage_rc(tid * 16 + i * 8192, R, C); const int Rb = Epi::PERM ? ((R & ~31) + perm32(R & 31)) : R;
        voffA[i] = (unsigned)(R * lda + C) * 2u; voffB[i] = (unsigned)(Rb * K + C) * 2u; }
    const size_t kstep = (size_t)(BK * 2);
    const size_t hstepA = (size_t)HALF * lda * 2, hstepB = (size_t)HALF * K * 2;
    const size_t tstepA = 2 * hstepA, tstepB = 2 * hstepB;
    const unsigned ldsw = (unsigned)wid * 1024u;
    const int aoff = lds_byte(wr * 64 + fr, fq * 8), boff = lds_byte(wc * 32 + fr, fq * 8);
#define PG8_SA(b, h) (((b) * 2 + (h)) * HTB)
#define PG8_SB(b, h) ((4 + (b) * 2 + (h)) * HTB)
#define PG8_STAGE(bufoff, gbase, voff) do { _Pragma("unroll") for (int _i = 0; _i < 2; ++_i) \
        __builtin_amdgcn_global_load_lds((const GAS unsigned*)((const GAS char*)(gbase) + (voff)[_i]), (LAS unsigned*)(lds + (bufoff) + ldsw + _i * 8192), 16, 0, 0); } while (0)
#define PG8_LDA(dst, b, h) do { _Pragma("unroll") for (int m = 0; m < 4; ++m) _Pragma("unroll") for (int k = 0; k < 2; ++k) dst[m][k] = *(const LAS bf16x8*)(lds + PG8_SA(b, h) + aoff + m * 2048 + k * 1024); } while (0)
#define PG8_LDB(dst, b, h) do { _Pragma("unroll") for (int n = 0; n < 2; ++n) _Pragma("unroll") for (int k = 0; k < 2; ++k) dst[n][k] = *(const LAS bf16x8*)(lds + PG8_SB(b, h) + boff + n * 2048 + k * 1024); } while (0)
#define PG8_MMA(ai, bj, At, Bt) do { __builtin_amdgcn_s_setprio(1); _Pragma("unroll") for (int m = 0; m < 4; ++m) _Pragma("unroll") for (int n = 0; n < 2; ++n) _Pragma("unroll") for (int k = 0; k < 2; ++k) \
        acc[ai][bj][m][n] = __builtin_amdgcn_mfma_f32_16x16x32_bf16(Bt[n][k], At[m][k], acc[ai][bj][m][n], 0, 0, 0); __builtin_amdgcn_s_setprio(0); } while (0)
#define PG8_WAIT_V(n) asm volatile("s_waitcnt vmcnt(" #n ")" ::: "memory")
#define PG8_WAIT_L(n) asm volatile("s_waitcnt lgkmcnt(" #n ")" ::: "memory")
#define PG8_BAR __builtin_amdgcn_s_barrier()
#define PG8_SCHED __builtin_amdgcn_sched_barrier(0)
    Unit cur, nxt; int ui = 0;
    if (!S.next(0, cur)) return;
    LAS float* rtab = (LAS float*)(lds + 131072);
    if constexpr (Epi::RSTD) {
        const int rrow = tid >> 1, part = tid & 1;
        for (int i0 = 0;; i0 += 4) {
            Unit un[4]; bool ok[4]; f32x4 p0[4], p1[4];
#pragma unroll
            for (int k = 0; k < 4; ++k) { ok[k] = S.next(i0 + k, un[k]); const int row = (ok[k] ? un[k].pm : cur.pm) * BM + rrow;
                const GAS f32x4* pp = (const GAS f32x4*)(E.p.ssq + (size_t)row * 16) + 2 * part; p0[k] = pp[0]; p1[k] = pp[1]; }
#pragma unroll
            for (int k = 0; k < 4; ++k) { float s = ((p0[k][0] + p0[k][1]) + (p0[k][2] + p0[k][3])) + ((p1[k][0] + p1[k][1]) + (p1[k][2] + p1[k][3]));
                s += __shfl_xor(s, 1);
                if (ok[k] && part == 0) rtab[(i0 + k) * BM + rrow] = __builtin_amdgcn_rsqf(s * E.p.inv_dim + EPS); }
            if (!ok[3]) break;
        }
        __syncthreads();
    }
    f32x4 acc[2][2][4][2];
#pragma unroll
    for (int a = 0; a < 2; ++a)
#pragma unroll
        for (int b = 0; b < 2; ++b)
#pragma unroll
            for (int m = 0; m < 4; ++m)
#pragma unroll
                for (int n = 0; n < 2; ++n) acc[a][b][m][n] = (f32x4){0.f, 0.f, 0.f, 0.f};
    bf16x8 At[4][2], B0[2][2], B1[2][2];
    const GAS char* cA = (const GAS char*)g.A + (size_t)cur.pm * tstepA; const GAS char* cB = (const GAS char*)g.Bt + (size_t)cur.pn * tstepB;
    PG8_STAGE(PG8_SB(0, 0), cB, voffB); PG8_STAGE(PG8_SB(0, 1), cB + hstepB, voffB); PG8_STAGE(PG8_SA(0, 0), cA, voffA); PG8_STAGE(PG8_SA(0, 1), cA + hstepA, voffA);
    if (wr == 1) PG8_BAR;
    PG8_WAIT_V(2); PG8_BAR;
    PG8_STAGE(PG8_SB(1, 0), cB + kstep, voffB); PG8_STAGE(PG8_SA(1, 0), cA + kstep, voffA); PG8_STAGE(PG8_SB(1, 1), cB + hstepB + kstep, voffB);
    PG8_WAIT_V(6); PG8_BAR;
    for (;;) {
        const bool has_next = S.next(ui + 1, nxt);
        const GAS char* nA = has_next ? (const GAS char*)g.A + (size_t)nxt.pm * tstepA : cA; const GAS char* nB = has_next ? (const GAS char*)g.Bt + (size_t)nxt.pn * tstepB : cB;
        for (int t = 0; t < nt; t += 2) {
            const bool last = (t == nt - 2);
            const GAS char* a1 = cA + (size_t)(t + 1) * kstep;
            const GAS char* a2 = last ? nA : cA + (size_t)(t + 2) * kstep; const GAS char* b2 = last ? nB : cB + (size_t)(t + 2) * kstep;
            const GAS char* a3 = a2 + kstep; const GAS char* b3 = b2 + kstep;
            PG8_LDB(B0, 0, 0); PG8_LDB(B1, 0, 1); PG8_SCHED; PG8_LDA(At, 0, 0); PG8_STAGE(PG8_SA(1, 1), a1 + hstepA, voffA);
            PG8_WAIT_V(8); PG8_WAIT_L(0); PG8_BAR; PG8_MMA(0, 0, At, B0); PG8_MMA(0, 1, At, B1); PG8_BAR; PG8_SCHED;
            PG8_LDA(At, 0, 1); PG8_STAGE(PG8_SB(0, 0), b2, voffB); PG8_STAGE(PG8_SB(0, 1), b2 + hstepB, voffB); PG8_STAGE(PG8_SA(0, 0), a2, voffA);
            PG8_WAIT_V(8); PG8_WAIT_L(0); PG8_BAR; PG8_MMA(1, 0, At, B0); PG8_MMA(1, 1, At, B1); PG8_BAR; PG8_SCHED;
            PG8_LDB(B0, 1, 0); PG8_LDB(B1, 1, 1); PG8_SCHED; PG8_LDA(At, 1, 0); PG8_STAGE(PG8_SA(0, 1), a2 + hstepA, voffA);
            PG8_WAIT_V(8); PG8_WAIT_L(0); PG8_BAR; PG8_MMA(0, 0, At, B0); PG8_MMA(0, 1, At, B1); PG8_BAR; PG8_SCHED;
            PG8_LDA(At, 1, 1); PG8_STAGE(PG8_SB(1, 0), b3, voffB); PG8_STAGE(PG8_SB(1, 1), b3 + hstepB, voffB); PG8_STAGE(PG8_SA(1, 0), a3, voffA);
            PG8_WAIT_V(8); PG8_WAIT_L(0); PG8_BAR; PG8_MMA(1, 0, At, B0); PG8_MMA(1, 1, At, B1); PG8_BAR; PG8_SCHED;
        }
        if (wr == 0) PG8_BAR;
        E(acc, cur, wr, wc, fr, fq, rtab + ui * BM);
        if (!has_next) break;
#pragma unroll
        for (int a = 0; a < 2; ++a)
#pragma unroll
            for (int b = 0; b < 2; ++b)
#pragma unroll
                for (int m = 0; m < 4; ++m)
#pragma unroll
                    for (int n = 0; n < 2; ++n) acc[a][b][m][n] = (f32x4){0.f, 0.f, 0.f, 0.f};
        cur = nxt; cA = nA; cB = nB; ++ui;
        if (wr == 1) PG8_BAR;
    }
    PG8_WAIT_V(0);
    PG8_BAR;
#undef PG8_SA
#undef PG8_SB
#undef PG8_STAGE
#undef PG8_LDA
#undef PG8_LDB
#undef PG8_MMA
#undef PG8_WAIT_V
#undef PG8_WAIT_L
#undef PG8_BAR
#undef PG8_SCHED
}
}

struct AttnArgs {
    const GAS bf16_t* Q; int qpitch;
    const GAS bf16_t* K1; int k1pitch;
    const GAS bf16_t* K2; int k2pitch;
    const GAS bf16_t* V; int vpitch;
    GAS bf16_t* O; int opitch;
    long qrow0, kvrow0; int dil;
    int q0, tlo, thi, W;
    float scale2, sink2;
    const GAS float* rc; const GAS float* rs;
    int omode;
    GAS float* lse_out; const GAS float* lse_a; const GAS float* lse_b; const GAS bf16_t* Oa; const GAS bf16_t* Ob; int head;
};
DI int crow(int r, int hi) { return (r & 3) + 8 * (r >> 2) + 4 * hi; }
DI void unpack8(const u32x4 r, float (&f)[8]) { f[0] = bflo(r.x); f[1] = bfhi(r.x); f[2] = bflo(r.y); f[3] = bfhi(r.y); f[4] = bflo(r.z); f[5] = bfhi(r.z); f[6] = bflo(r.w); f[7] = bfhi(r.w); }
DI bf16x8 pack8(const float (&f)[8]) { u32x4 w; w.x = cvtpk(f[0], f[1]); w.y = cvtpk(f[2], f[3]); w.z = cvtpk(f[4], f[5]); w.w = cvtpk(f[6], f[7]); return __builtin_bit_cast(bf16x8, w); }
typedef short v4i16_t __attribute__((ext_vector_type(4)));
DI s16x4 vtr(LAS const unsigned char* p) { return __builtin_bit_cast(s16x4, __builtin_amdgcn_ds_read_tr16_b64_v4i16((LAS v4i16_t*)p)); }

template <int DQK, int DV, int MASK>
DI void attn_tile(const LAS unsigned char* kb, const LAS unsigned char* vb, const bf16x8 (&qf)[DQK / 16], f32x16 (&o)[DV / 32], float& m, float& l, f32x16& negm, const bool fast,
                  const int t, const int qn, const int qw0, const int half, const int W) {
    constexpr int KSTR = DQK * 2 + 16, VSTR = DV * 2 + 64, NS = DQK / 16, ND = DV / 32;
            constexpr bool FIXREF = (DV / 32 <= 2);
            f32x16 x0, x1;
            if (FIXREF && fast) { x0 = negm; x1 = negm; }
            else {
#pragma unroll
                for (int r = 0; r < 16; ++r) { x0[r] = 0.f; x1[r] = 0.f; }
            }
            constexpr int KCH_STEPS = (NS > 6) ? 2 : NS;
            constexpr bool VPRE = (ND <= 2);
#pragma unroll
            for (int c0 = 0; c0 < NS; c0 += KCH_STEPS) {
                bf16x8 ka[KCH_STEPS], kc[KCH_STEPS];
#pragma unroll
                for (int s = 0; s < KCH_STEPS; ++s) { ka[s] = *(const LAS bf16x8*)(kb + (c0 + s) * 32); kc[s] = *(const LAS bf16x8*)(kb + 32 * KSTR + (c0 + s) * 32); }
                __builtin_amdgcn_sched_barrier(0);
                __builtin_amdgcn_s_setprio(1);
#pragma unroll
                for (int s = 0; s < KCH_STEPS; ++s) {
                    x0 = __builtin_amdgcn_mfma_f32_32x32x16_bf16(ka[s], qf[c0 + s], x0, 0, 0, 0);
                    x1 = __builtin_amdgcn_mfma_f32_32x32x16_bf16(kc[s], qf[c0 + s], x1, 0, 0, 0);
                }
                __builtin_amdgcn_s_setprio(0);
                __builtin_amdgcn_sched_barrier(0);
            }
            s16x4 vl[4], vh[4];
            if (VPRE) {
#pragma unroll
                for (int s = 0; s < 4; ++s) { vl[s] = vtr(vb + (16 * s) * VSTR); vh[s] = vtr(vb + (16 * s + 8) * VSTR); }
                __builtin_amdgcn_sched_barrier(0);
            }
            if (MASK != 0) {
                const bool need = (MASK == 1) ? (t * 64 + 63 > qw0) : !((t * 64 + 63 <= qw0) && (qw0 + 31 - t * 64 <= W));
                if (need) {
                    const int dbase = qn - (t * 64 + 4 * half);
#pragma unroll
                    for (int r = 0; r < 16; ++r) { const int d0 = dbase - ((r & 3) + 8 * (r >> 2)), d1 = d0 - 32;
                        const bool v0 = (MASK == 1) ? (d0 >= 0) : ((unsigned)d0 <= (unsigned)W), v1 = (MASK == 1) ? (d1 >= 0) : ((unsigned)d1 <= (unsigned)W);
                        x0[r] = v0 ? x0[r] : -INFINITY; x1[r] = v1 ? x1[r] : -INFINITY; }
                }
            }
            if (!(FIXREF && fast)) {
            float mx;
            {
#define MX3(a, b, c) __builtin_fmaxf(__builtin_fmaxf((a), (b)), (c))
                float ma = MX3(x0[0], x0[1], x1[0]), mb = MX3(x0[2], x0[3], x1[1]); ma = MX3(ma, x1[2], x1[3]);
#pragma unroll
                for (int r = 4; r < 16; r += 4) { ma = MX3(ma, x0[r], x0[r + 1]); mb = MX3(mb, x0[r + 2], x0[r + 3]); ma = MX3(ma, x1[r], x1[r + 1]); mb = MX3(mb, x1[r + 2], x1[r + 3]); }
#undef MX3
                mx = fmaxf(ma, mb);
            }
            mx = fmaxf(mx, __shfl_xor(mx, 32));
            const float mn = fmaxf(m, mx), ms = (mn == -INFINITY) ? 0.f : mn;
            if (__any(mn > m)) {
                const float alpha = __builtin_amdgcn_exp2f(m - ms);
                l *= alpha;
#pragma unroll
                for (int d = 0; d < ND; ++d)
#pragma unroll
                    for (int r = 0; r < 16; ++r) o[d][r] *= alpha;
            }
            m = mn;
            float rsum = 0.f;
#pragma unroll
            for (int r = 0; r < 16; ++r) { x0[r] = __builtin_amdgcn_exp2f(x0[r] - ms); x1[r] = __builtin_amdgcn_exp2f(x1[r] - ms); rsum += x0[r] + x1[r]; }
            l += rsum;
            if (FIXREF) {
                m = ms;
#pragma unroll
                for (int r = 0; r < 16; ++r) negm[r] = -ms;
            }
            } else {
                float rsum = 0.f;
#pragma unroll
                for (int r = 0; r < 16; ++r) { x0[r] = __builtin_amdgcn_exp2f(x0[r]); x1[r] = __builtin_amdgcn_exp2f(x1[r]); rsum += x0[r] + x1[r]; }
                l += rsum;
            }
            bf16x8 pk[4];
            { u32x4 w;
              w.x = cvtpk(x0[0], x0[1]); w.y = cvtpk(x0[2], x0[3]); w.z = cvtpk(x0[4], x0[5]); w.w = cvtpk(x0[6], x0[7]); pk[0] = __builtin_bit_cast(bf16x8, w);
              w.x = cvtpk(x0[8], x0[9]); w.y = cvtpk(x0[10], x0[11]); w.z = cvtpk(x0[12], x0[13]); w.w = cvtpk(x0[14], x0[15]); pk[1] = __builtin_bit_cast(bf16x8, w);
              w.x = cvtpk(x1[0], x1[1]); w.y = cvtpk(x1[2], x1[3]); w.z = cvtpk(x1[4], x1[5]); w.w = cvtpk(x1[6], x1[7]); pk[2] = __builtin_bit_cast(bf16x8, w);
              w.x = cvtpk(x1[8], x1[9]); w.y = cvtpk(x1[10], x1[11]); w.z = cvtpk(x1[12], x1[13]); w.w = cvtpk(x1[14], x1[15]); pk[3] = __builtin_bit_cast(bf16x8, w); }
            __builtin_amdgcn_sched_barrier(0);
            if (!VPRE) {
#pragma unroll
                for (int s = 0; s < 4; ++s) { vl[s] = vtr(vb + (16 * s) * VSTR); vh[s] = vtr(vb + (16 * s + 8) * VSTR); }
                __builtin_amdgcn_sched_barrier(0);
            }
#pragma unroll
            for (int d = 0; d < ND; ++d) {
                s16x4 nl[4], nh[4];
                if (d + 1 < ND) {
#pragma unroll
                    for (int s = 0; s < 4; ++s) { nl[s] = vtr(vb + (16 * s) * VSTR + (d + 1) * 64); nh[s] = vtr(vb + (16 * s + 8) * VSTR + (d + 1) * 64); }
                    __builtin_amdgcn_sched_barrier(0);
                }
                __builtin_amdgcn_s_setprio(1);
#pragma unroll
                for (int s = 0; s < 4; ++s) {
                    const bf16x8 vf = (bf16x8){vl[s][0], vl[s][1], vl[s][2], vl[s][3], vh[s][0], vh[s][1], vh[s][2], vh[s][3]};
                    o[d] = __builtin_amdgcn_mfma_f32_32x32x16_bf16(vf, pk[s], o[d], 0, 0, 0);
                }
                __builtin_amdgcn_s_setprio(0);
                if (d + 1 < ND) {
#pragma unroll
                    for (int s = 0; s < 4; ++s) { vl[s] = nl[s]; vh[s] = nh[s]; }
                }
                __builtin_amdgcn_sched_barrier(0);
            }

}

template <int DQK, int DV, int KC1, int MASK, int ROPE, bool ALLT = false, int TR = 64>
DI void attn_unit(LAS unsigned char* lds, const AttnArgs& a, const int tid_in, u32x4 (&sk)[6], u32x4 (&sv)[6], const bool pre, const bool has_next, const AttnArgs& an) {
    int tid = tid_in; asm volatile("" : "+v"(tid));
    constexpr int KSTR = DQK * 2 + 16, VSTR = DV * 2 + 64;
    constexpr int KB = TR * KSTR, VB = TR * VSTR, BUF = KB + VB;
    constexpr int KCPR = DQK / 8, VCPR = DV / 8, KCH = TR * KCPR, VCH = TR * VCPR, NCH = KCH + VCH, NI = (NCH + 511) / 512;
    constexpr int NS = DQK / 16, ND = DV / 32;
    const int lane = tid & 63, wave = __builtin_amdgcn_readfirstlane(tid >> 6), l31 = lane & 31, half = lane >> 5;

    constexpr bool UNI = (KC1 == KCPR);
    const int gsu = 2 * TR * a.dil * a.k1pitch;
    const GAS char* gp[NI]; unsigned lo[NI]; int gst[UNI ? 1 : NI];
#define GST(i) (UNI ? gsu : gst[UNI ? 0 : (i)])
#pragma unroll
    for (int i = 0; i < NI; ++i) {
        int cid = tid + 512 * i; gp[i] = (const GAS char*)(a.K1 + (a.kvrow0 + (long)(a.tlo * 64) * a.dil) * a.k1pitch); lo[i] = 2 * BUF + (tid & 255) * 16; if (!UNI) gst[i] = 0;
        if (cid < KCH) { const int row = cid / KCPR, c = cid % KCPR; const long grow = a.kvrow0 + (long)(a.tlo * 64 + row) * a.dil;
            if (c < KC1) { gp[i] = (const GAS char*)(a.K1 + grow * a.k1pitch + c * 8); if (!UNI) gst[i] = 2 * TR * a.dil * a.k1pitch; }
            else { gp[i] = (const GAS char*)(a.K2 + grow * a.k2pitch + (c - KC1) * 8); if (!UNI) gst[i] = 2 * TR * a.dil * a.k2pitch; }
            lo[i] = row * KSTR + c * 16; }
        else if (cid < NCH) { cid -= KCH; const int row = cid / VCPR, c = cid % VCPR; const long grow = a.kvrow0 + (long)(a.tlo * 64 + row) * a.dil;
            gp[i] = (const GAS char*)(a.V + grow * a.vpitch + c * 8); if (!UNI) gst[i] = 2 * TR * a.dil * a.vpitch; lo[i] = KB + row * VSTR + c * 16; }
    }
    u32x4 sA[NI], sB[NI];
    constexpr int NTMAX = 6;
    const int ntile = a.thi - a.tlo;
    if (ALLT) {
        if (!pre) {
            const int row = tid >> 3, c = tid & 7; const long grow = a.kvrow0 + (long)(a.tlo * 64 + row) * a.dil;
            const GAS char* kp0 = (const GAS char*)(a.K1 + grow * a.k1pitch + c * 8); const GAS char* vp0 = (const GAS char*)(a.V + grow * a.vpitch + c * 8);
#pragma unroll
            for (int tt = 0; tt < NTMAX; ++tt) { const int ts = tt < ntile ? tt : ntile - 1; sk[tt] = *(const GAS u32x4*)(kp0 + ts * gsu); sv[tt] = *(const GAS u32x4*)(vp0 + ts * gsu); }
        }
    } else {
#pragma unroll
        for (int i = 0; i < NI; ++i) sA[i] = *(const GAS u32x4*)(gp[i]);
        if (TR == 64 && NI <= 3 && a.tlo + 1 < a.thi) {
#pragma unroll
            for (int i = 0; i < NI; ++i) sB[i] = *(const GAS u32x4*)(gp[i] + GST(i));
        }
    }
    const int qn = a.q0 + wave * 32 + l31; const long qrow = a.qrow0 + (long)qn * a.dil;
    bf16x8 qf[NS];
    {
        const GAS bf16_t* qp = a.Q + qrow * a.qpitch + 8 * half;
        float f[NS][8];
#pragma unroll
        for (int s = 0; s < NS; ++s) unpack8(*(const GAS u32x4*)(qp + 16 * s), f[s]);
        if (ROPE == 1 && a.rc != nullptr) {
#pragma unroll
            for (int s = 0; s < 2; ++s) {
                const GAS f32x4* cp = (const GAS f32x4*)(a.rc + qrow * 32 + 16 * s + 8 * half); const GAS f32x4* sp = (const GAS f32x4*)(a.rs + qrow * 32 + 16 * s + 8 * half);
                const f32x4 c0 = cp[0], c1 = cp[1], s0 = sp[0], s1 = sp[1];
#pragma unroll
                for (int j = 0; j < 8; ++j) { const float c = j < 4 ? c0[j & 3] : c1[j & 3], sn = j < 4 ? s0[j & 3] : s1[j & 3];
                    const float x1 = f[s][j], x2 = f[s + 2][j]; f[s][j] = x1 * c - x2 * sn; f[s + 2][j] = x2 * c + x1 * sn; }
            }
        } else if (ROPE == 2) {
            const GAS f32x4* cp = (const GAS f32x4*)(a.rc + qrow * 16 + 8 * half); const GAS f32x4* sp = (const GAS f32x4*)(a.rs + qrow * 16 + 8 * half);
            const f32x4 c0 = cp[0], c1 = cp[1], s0 = sp[0], s1 = sp[1];
#pragma unroll
            for (int j = 0; j < 8; ++j) { const float c = j < 4 ? c0[j & 3] : c1[j & 3], sn = j < 4 ? s0[j & 3] : s1[j & 3];
                const float x1 = f[NS - 2][j], x2 = f[NS - 1][j]; f[NS - 2][j] = x1 * c - x2 * sn; f[NS - 1][j] = x2 * c + x1 * sn; }
        }
#pragma unroll
        for (int s = 0; s < NS; ++s) {
#pragma unroll
            for (int j = 0; j < 8; ++j) f[s][j] *= a.scale2;
            qf[s] = pack8(f[s]);
        }
    }
    float m = a.sink2, l = (a.sink2 > -1e30f && half == 0) ? 1.f : 0.f;
    f32x16 negm;
#pragma unroll
    for (int r = 0; r < 16; ++r) negm[r] = 0.f;
    f32x16 o[ND];
#pragma unroll
    for (int d = 0; d < ND; ++d)
#pragma unroll
        for (int r = 0; r < 16; ++r) o[d][r] = 0.f;

    const int qw0 = a.q0 + wave * 32;
    int wlo = a.tlo, whi = a.thi;
    if (MASK >= 1) { const int e = (qw0 + 31) / 64 + 1; whi = e < whi ? e : whi; }
    if (MASK == 2) { const int s0 = qw0 - a.W; const int b = s0 > 0 ? s0 / 64 : 0; wlo = b > wlo ? b : wlo; }

    const LAS unsigned char* kfrag = lds + l31 * KSTR + half * 16;
    const LAS unsigned char* vfrag = lds + KB + (4 * half + ((lane & 15) >> 2)) * VSTR + ((lane >> 4) & 1) * 32 + (lane & 3) * 8;

    if constexpr (TR == 128) {
        __syncthreads();
#pragma unroll
        for (int i = 0; i < NI; ++i) *(LAS u32x4*)(lds + lo[i]) = sA[i];
        __syncthreads();
        for (int t = a.tlo; t < a.thi; t += 2) {
            const int cur = ((t - a.tlo) >> 1) & 1;
            if (t + 2 < a.thi) {
#pragma unroll
                for (int i = 0; i < NI; ++i) sA[i] = *(const GAS u32x4*)(gp[i] + ((t + 2 - a.tlo) >> 1) * GST(i));
            }
            if (t >= wlo && t < whi) attn_tile<DQK, DV, MASK>(kfrag + cur * BUF, vfrag + cur * BUF, qf, o, m, l, negm, t != wlo, t, qn, qw0, half, a.W);
            if (t + 1 >= wlo && t + 1 < whi) attn_tile<DQK, DV, MASK>(kfrag + cur * BUF + 64 * KSTR, vfrag + cur * BUF + 64 * VSTR, qf, o, m, l, negm, t + 1 != wlo, t + 1, qn, qw0, half, a.W);
            if (t + 2 < a.thi) {
#pragma unroll
                for (int i = 0; i < NI; ++i) *(LAS u32x4*)(lds + ((tid + 512 * i < NCH) ? (cur ^ 1) * BUF : 0) + lo[i]) = sA[i];
            }
            __syncthreads();
        }
    } else
    if (!ALLT) {
    if (NI > 3 && a.tlo + 1 < a.thi) {
#pragma unroll
        for (int i = 0; i < NI; ++i) sB[i] = *(const GAS u32x4*)(gp[i] + GST(i));
    }
    __syncthreads();
#pragma unroll
    for (int i = 0; i < NI; ++i) *(LAS u32x4*)(lds + lo[i]) = sA[i];
    __syncthreads();
#define ATT_ITER(PEND, NEW) { \
        const int cur = (t - a.tlo) & 1; \
        if (t + 2 < a.thi) { _Pragma("unroll") for (int i = 0; i < NI; ++i) NEW[i] = *(const GAS u32x4*)(gp[i] + (t + 2 - a.tlo) * GST(i)); } \
        if (t >= wlo && t < whi) attn_tile<DQK, DV, MASK>(kfrag + cur * BUF, vfrag + cur * BUF, qf, o, m, l, negm, t != wlo, t, qn, qw0, half, a.W); \
        if (t + 1 < a.thi) { _Pragma("unroll") for (int i = 0; i < NI; ++i) *(LAS u32x4*)(lds + ((tid + 512 * i < NCH) ? (cur ^ 1) * BUF : 0) + lo[i]) = PEND[i]; } \
        __syncthreads(); }
    for (int t = a.tlo;;) {
        ATT_ITER(sB, sA)
        if (++t >= a.thi) break;
        ATT_ITER(sA, sB)
        if (++t >= a.thi) break;
    }
#undef ATT_ITER
#undef GST
    } else {
        __syncthreads();
        { const int row = tid >> 3, c = tid & 7;
#pragma unroll
          for (int tt = 0; tt < (ALLT ? NTMAX : 1); ++tt) { *(LAS u32x4*)(lds + tt * BUF + row * KSTR + c * 16) = sk[tt]; *(LAS u32x4*)(lds + tt * BUF + KB + row * VSTR + c * 16) = sv[tt]; } }
        __syncthreads();
        if (has_next) {
            const int row = tid >> 3, c = tid & 7; const long grow = an.kvrow0 + (long)(an.tlo * 64 + row) * an.dil; const int nnt = an.thi - an.tlo, ngs = 128 * an.dil * an.k1pitch;
            const GAS char* kp0 = (const GAS char*)(an.K1 + grow * an.k1pitch + c * 8); const GAS char* vp0 = (const GAS char*)(an.V + grow * an.vpitch + c * 8);
#pragma unroll
            for (int tt = 0; tt < (ALLT ? NTMAX : 1); ++tt) { const int ts = tt < nnt ? tt : nnt - 1; sk[tt] = *(const GAS u32x4*)(kp0 + ts * ngs); sv[tt] = *(const GAS u32x4*)(vp0 + ts * ngs); }
        }
        for (int t = wlo; t < whi; ++t) attn_tile<DQK, DV, MASK>(kfrag + (t - a.tlo) * BUF, vfrag + (t - a.tlo) * BUF, qf, o, m, l, negm, t != wlo, t, qn, qw0, half, a.W);
        __syncthreads();
    }

    const float lt = l + __shfl_xor(l, 32);
    float wself = __builtin_amdgcn_rcpf(lt), wa = 0.f, wb = 0.f;
    if (a.omode == 1) { if (half == 0) a.lse_out[qrow * 16 + a.head] = m + __builtin_amdgcn_logf(lt); }
    if (a.omode == 2) {
        const float L3 = m + __builtin_amdgcn_logf(lt), La = a.lse_a[qrow * 16 + a.head], Lb = a.lse_b[qrow * 16 + a.head];
        const float M = fmaxf(L3, fmaxf(La, Lb));
        const float ea = __builtin_amdgcn_exp2f(La - M), eb = __builtin_amdgcn_exp2f(Lb - M), e3 = __builtin_amdgcn_exp2f(L3 - M);
        const float inv = __builtin_amdgcn_rcpf(ea + eb + e3);
        wa = ea * inv; wb = eb * inv; wself = e3 * inv * wself;
    }
    constexpr int OSTR = DV * 2 + 16, OST0 = ALLT ? 0 : 2 * BUF + 4096;
    LAS unsigned char* stg = lds + OST0 + wave * (32 * OSTR);
#pragma unroll
    for (int d = 0; d < ND; ++d)
#pragma unroll
        for (int g = 0; g < 4; ++g) {
            float v0 = o[d][4 * g] * wself, v1 = o[d][4 * g + 1] * wself, v2 = o[d][4 * g + 2] * wself, v3 = o[d][4 * g + 3] * wself;
            const int col = 32 * d + 8 * g;
            if (a.omode == 2) {
                const u32x2 pa = *(const GAS u32x2*)(a.Oa + qrow * a.opitch + 4 * half + col), pb = *(const GAS u32x2*)(a.Ob + qrow * a.opitch + 4 * half + col);
                v0 += wa * bflo(pa.x) + wb * bflo(pb.x); v1 += wa * bfhi(pa.x) + wb * bfhi(pb.x);
                v2 += wa * bflo(pa.y) + wb * bflo(pb.y); v3 += wa * bfhi(pa.y) + wb * bfhi(pb.y);
            }
            u32x2 w; w.x = cvtpk(v0, v1); w.y = cvtpk(v2, v3);
            *(LAS u32x2*)(stg + l31 * OSTR + (col + 4 * half) * 2) = w;
        }
    asm volatile("s_waitcnt lgkmcnt(0)" ::: "memory");
    {
        constexpr int CPR = DV / 8, RPI = 64 / CPR;
        const int rr = lane / CPR, ch = lane % CPR;
#pragma unroll
        for (int i = 0; i < 32 / RPI; ++i) {
            const int row = i * RPI + rr;
            const u32x4 v = *(const LAS u32x4*)(stg + row * OSTR + ch * 16);
            const long grow = a.qrow0 + (long)(a.q0 + wave * 32 + row) * a.dil;
            *(GAS u32x4*)(a.O + grow * a.opitch + ch * 8) = v;
        }
    }
}

DI AttnArgs band_args(int u, int layer, int dil, GAS bf16_t* BIG, GAS bf16_t* R1, GAS bf16_t* R2, GAS float* LSE1, GAS float* LSE2, const GAS float* R64C, const GAS float* R64S, const GAS float* sinks) {
    AttnArgs a{};
    a.rc = R64C; a.rs = R64S; a.scale2 = 0.125f * LOG2E;
    if (layer == 0) {
        const int qb = u & 31, h = (u >> 5) & 7, b = u >> 8, kvh = h >> 2;
        a.Q = BIG + h * 64; a.qpitch = ZP; a.K1 = BIG + Z_KA + kvh * 64; a.k1pitch = ZP; a.K2 = a.K1; a.k2pitch = ZP; a.V = BIG + Z_VA + kvh * 64; a.vpitch = ZP;
        a.O = R2 + h * 64; a.opitch = D; a.qrow0 = (long)b * S; a.kvrow0 = a.qrow0; a.dil = 1; a.q0 = qb * 256; a.W = 127;
        a.tlo = qb * 4 - 2 < 0 ? 0 : qb * 4 - 2; a.thi = qb * 4 + 4;
        a.sink2 = sinks[h] * LOG2E; a.omode = 0; a.head = h;
    } else {
        const int nblk = 32 / dil; const int nb = u % nblk, r = (u / nblk) % dil, h = (u >> 5) & 15, b = u >> 9;
        const size_t slab = ((size_t)b * 15 * S + (size_t)h * S) * 64;
        a.Q = BIG + slab; a.qpitch = 64; a.K1 = BIG + (size_t)T * 1024 + slab; a.k1pitch = 64; a.K2 = a.K1; a.k2pitch = 64; a.V = BIG + (size_t)T * 2048 + slab; a.vpitch = 64;
        a.opitch = D; a.qrow0 = (long)b * S + r; a.kvrow0 = a.qrow0; a.dil = dil; a.q0 = nb * 256; a.W = 128;
        a.tlo = nb * 4 - 2 < 0 ? 0 : nb * 4 - 2; a.thi = nb * 4 + 4;
        a.sink2 = -INFINITY; a.head = h; a.rc = nullptr; a.rs = nullptr; a.scale2 = 1.f;
        if (dil == 1) { a.omode = 1; a.O = R1 + h * 64; a.lse_out = LSE1; }
        else if (dil == 4) { a.omode = 1; a.O = R2 + h * 64; a.lse_out = LSE2; }
        else { a.omode = 2; a.O = R1 + h * 64; a.Oa = R1 + h * 64; a.Ob = R2 + h * 64; a.lse_a = LSE1; a.lse_b = LSE2; }
    }
    return a;
}

DI void wt_item(const GAS float* W, int ldw, int K, const GAS float* g, GAS bf16_t* Bt, int roff, int rbs, int ncols, int nblk, int item, LAS float* scr, int lane, int rp_lo = 0, int rp_hi = 0) {
    const int kb = item / nblk, nb = item % nblk, k0 = 64 * kb, c0 = 32 * nb;
    const int c = c0 + (lane & 31);
    float wv[32];
    const int cl = c < ncols ? c : ncols - 1;
#pragma unroll
    for (int i = 0; i < 32; ++i) wv[i] = W[(size_t)(k0 + 2 * i + (lane >> 5)) * ldw + cl];
    const float gsel = (c < ncols) ? 1.f : 0.f;
#pragma unroll
    for (int i = 0; i < 32; ++i) { const int kk = 2 * i + (lane >> 5); float v = wv[i] * gsel; if (g) v *= g[k0 + kk]; scr[kk * 33 + (lane & 31)] = v; }
    asm volatile("s_waitcnt lgkmcnt(0)" ::: "memory");
    const int cch = lane & 7;
#pragma unroll
    for (int j = 0; j < 4; ++j) { const int n = (lane >> 3) + 8 * j; const LAS float* s = scr + (8 * cch) * 33 + n;
        u32x4 o; o.x = cvtpk(s[0 * 33], s[1 * 33]); o.y = cvtpk(s[2 * 33], s[3 * 33]); o.z = cvtpk(s[4 * 33], s[5 * 33]); o.w = cvtpk(s[6 * 33], s[7 * 33]);
        const int cc = c0 + n; int drow = roff + (cc >> 7) * rbs + (cc & 127);
        if (cc >= rp_lo && cc < rp_hi) drow = roff + (cc & ~255) + 128 * ((cc >> 5) & 1) + 32 * ((cc >> 6) & 3) + (cc & 31);
        *(GAS u32x4*)(Bt + (size_t)drow * K + k0 + 8 * cch) = o; }
    asm volatile("s_waitcnt lgkmcnt(0)" ::: "memory");
}
DI void row_to_bf16(const GAS float* xrow, GAS bf16_t* orow, GAS float* ssq16, int lane) {
    const GAS f32x4* xr = (const GAS f32x4*)xrow + lane; f32x4 v[4]; float s = 0.f;
#pragma unroll
    for (int j = 0; j < 4; ++j) { v[j] = xr[64 * j]; s += (v[j][0] * v[j][0] + v[j][1] * v[j][1]) + (v[j][2] * v[j][2] + v[j][3] * v[j][3]); }
    s = wave_sum(s);
    GAS u32x2* o8 = (GAS u32x2*)orow + lane;
#pragma unroll
    for (int j = 0; j < 4; ++j) { u32x2 w; w.x = cvtpk(v[j][0], v[j][1]); w.y = cvtpk(v[j][2], v[j][3]); o8[64 * j] = w; }
    if (lane < 16) ssq16[lane] = lane == 0 ? s : 0.f;
}


#define XB_TMO      128
#define XB_XCNT(j)  (256  + 64 * (j))
#define XB_XSUB(j)  (1280 + 64 * (j))
#define XB_XGEN(j)  (2304 + 64 * (j))
#define XB_TOP      3328
#define XB_TOPGEN   3392
#define XCD_BAR_WORDS 3456
#define XB_SPIN_CAP (1u << 22)
DI unsigned xb_ld(unsigned* p)              { return __hip_atomic_load(p, __ATOMIC_RELAXED, __HIP_MEMORY_SCOPE_AGENT); }
DI unsigned xb_add(unsigned* p, unsigned v) { return __hip_atomic_fetch_add(p, v, __ATOMIC_RELAXED, __HIP_MEMORY_SCOPE_AGENT); }
DI unsigned xb_xcc_id() { return (unsigned)__builtin_amdgcn_s_getreg((3 << 11) | 20) & 0xFu; }
#define XB_SPIN(cond, bar) do { unsigned _sp = 0; while (cond) { __builtin_amdgcn_s_sleep(1); \
    if ((++_sp & 255u) == 0u) { if (xb_ld(&(bar)[XB_TMO])) break; if (_sp > XB_SPIN_CAP) { atomicAdd(&(bar)[XB_TMO], 1u); break; } } } } while (0)
struct XcdBarrier { unsigned* bar; unsigned x; volatile LAS unsigned* st; };
DI XcdBarrier xcd_barrier_post(unsigned* bar, volatile LAS unsigned* st) {
    XcdBarrier b; b.bar = bar; b.x = xb_xcc_id(); b.st = st;
    if (threadIdx.x == 0) (void)xb_add(&bar[XB_XCNT(b.x)], 1u);
    return b;
}
DI void xcd_barrier_complete(unsigned* bar, unsigned x, unsigned& nloc, unsigned& nx) {
    const unsigned G = gridDim.x * gridDim.y * gridDim.z;
    unsigned sum, cnt, mine, sp = 0u;
    for (;;) {
        sum = 0u; cnt = 0u; mine = 0u;
#pragma unroll
        for (unsigned j = 0; j < 16; ++j) { const unsigned c = xb_ld(&bar[XB_XCNT(j)]); sum += c; cnt += (c > 0u) ? 1u : 0u; mine = (j == x) ? c : mine; }
        if (sum == G) break;
        __builtin_amdgcn_s_sleep(1);
        if ((++sp & 255u) == 0u) { if (xb_ld(&bar[XB_TMO])) break; if (sp > XB_SPIN_CAP) { atomicAdd(&bar[XB_TMO], 1u); break; } }
    }
    nloc = mine > 0u ? mine : 1u; nx = cnt > 0u ? cnt : 1u;
}
DI void xcd_barrier(const XcdBarrier& b) {
    asm volatile("s_waitcnt vmcnt(0)" ::: "memory");
    __syncthreads();
    if (threadIdx.x == 0) {
        unsigned* bar = b.bar;
        __builtin_amdgcn_s_waitcnt(0);
        unsigned nloc = b.st[0], nx = b.st[1];
        if (nloc == 0u) { xcd_barrier_complete(bar, b.x, nloc, nx); b.st[0] = nloc; b.st[1] = nx; }
        const unsigned old = xb_add(&bar[XB_XSUB(b.x)], 1u);
        const unsigned gen = old / nloc;
        if (old + 1u == (gen + 1u) * nloc) {
            __builtin_amdgcn_fence(__ATOMIC_RELEASE, "agent");
            asm volatile("s_waitcnt vmcnt(0)" ::: "memory");
            const unsigned og = xb_add(&bar[XB_TOP], 1u);
            const unsigned tg = og / nx;
            if (og + 1u == (tg + 1u) * nx) xb_add(&bar[XB_TOPGEN], 1u);
            else XB_SPIN(xb_ld(&bar[XB_TOPGEN]) == tg, bar);
            __builtin_amdgcn_fence(__ATOMIC_ACQUIRE, "agent");
            xb_add(&bar[XB_XGEN(b.x)], 1u);
            asm volatile("s_waitcnt vmcnt(0)" ::: "memory");
        } else {
            XB_SPIN(xb_ld(&bar[XB_XGEN(b.x)]) == gen, bar);
            __builtin_amdgcn_fence(__ATOMIC_ACQUIRE, "agent");
            asm volatile("s_waitcnt vmcnt(0)" ::: "memory");
        }
    }
    __syncthreads();
}

#ifndef REPEAT_MASK
#define REPEAT_MASK 0u
#endif
struct Params { const void* in[33]; float* out; unsigned char* ws; int lo, hi; };

__global__ void __launch_bounds__(512, 2) fwd_kernel(Params P) {
    extern __shared__ __attribute__((aligned(16))) unsigned char lds_raw[];
    LAS unsigned char* lds = (LAS unsigned char*)lds_raw;
    cg::grid_group grid = cg::this_grid();
    const int wave0 = __builtin_amdgcn_readfirstlane(threadIdx.x >> 6);
    volatile LAS unsigned* bst = (volatile LAS unsigned*)(lds + 163840 - 64);
    if (threadIdx.x < 2) bst[threadIdx.x] = 0u;
    unsigned* barw = (unsigned*)P.ws;
    __syncthreads();
    if (P.hi < 0) grid.sync();
    XcdBarrier xbar = xcd_barrier_post(barw, bst);
    for (int st2 = 2 * P.lo; st2 < 2 * P.hi; ++st2) {
        const int st = st2 >> 1;
        if ((st2 & 1) && !((REPEAT_MASK >> st) & 1u)) continue;
        int zero; asm volatile("s_mov_b32 %0, 0" : "=s"(zero));
        int tid = wave0 * 64 + (int)__builtin_amdgcn_mbcnt_hi(~0u, __builtin_amdgcn_mbcnt_lo(~0u, 0u)); asm volatile("" : "+v"(tid));
        const int lane = tid & 63, wave = __builtin_amdgcn_readfirstlane(tid >> 6);
        GAS unsigned char* ws = (GAS unsigned char*)P.ws; asm volatile("" : "+s"(ws));
        int G = gridDim.x, bid = blockIdx.x; asm volatile("" : "+s"(G), "+s"(bid));
        const int gw = bid * 8 + wave, NGW = G * 8;
        const int vcu = (G == 256) ? (bid & 7) * 32 + (bid >> 3) : bid;
#define WSB(off) ((GAS bf16_t*)(ws + (off) * MiB))
#define WSF(off) ((GAS float*)(ws + (off) * MiB))
#define PIN(k) (P.in[(k) + zero])
        const GAS float* x_in = (const GAS float*)PIN(0); const GAS float* mem_in = (const GAS float*)PIN(1); const GAS int* pos_in = (const GAS int*)PIN(2);
        GAS float* X = (GAS float*)P.out; asm volatile("" : "+s"(X));
        GAS bf16_t* XB = WSB(O_XB); GAS bf16_t* BIG = WSB(O_BIG); GAS bf16_t* R1 = WSB(O_R1); GAS bf16_t* R2 = WSB(O_R2); GAS bf16_t* OB = WSB(O_OB);
        GAS bf16_t* QB = BIG + (size_t)T * ZP;
        GAS bf16_t* QX = R2; GAS bf16_t* OX = R2 + (size_t)T * 512;
        GAS bf16_t* MEMB = WSB(O_MEMB); GAS bf16_t* MEMKV = WSB(O_MEMKV);
        GAS float* SSQ = WSF(O_SSQ); GAS float* SSQQ = WSF(O_SSQQ); GAS float* SSQKV = WSF(O_SSQKV); GAS float* MEMSSQ = WSF(O_MEMSSQ);
        GAS float* R64C = WSF(O_R64C); GAS float* R64S = WSF(O_R64S); GAS float* R32C = WSF(O_R32C); GAS float* R32S = WSF(O_R32S);
        GAS float* LSE1 = WSF(O_LSE1); GAS float* LSE2 = WSF(O_LSE2);
        int kind = 0;
        bool sync_after = true;
        pg8::Gemm g{nullptr, nullptr, 0, 0, 0, 0}; pg8::EpiP e{nullptr, 0, nullptr, 0.f, nullptr, nullptr, nullptr, nullptr, nullptr, nullptr, nullptr, 0, 0};
        e.X16 = (GAS _Float16*)WSB(O_OB); int rmode = 1;
        int layer = 0, dil = 1;
        switch (st) {
        case 1: kind = 1; g = {XB, WSB(W_IN), T, ZP, D, D}; e.O = BIG; e.ldc = ZP; e.ssq = SSQ; e.inv_dim = 1.f / D; sync_after = false; break;
        case 2: kind = 1; g = {MEMB, WSB(W_XKV), MROWS, 2048, D, D}; e.O = MEMKV; e.ldc = 2048; e.ssq = MEMSSQ; e.inv_dim = 1.f / D; break;
        case 4: kind = 1; g = {BIG + Z_CQ, WSB(W_UQ), T, 768, 384, ZP}; e.O = QB; e.ldc = 768; e.ssq = SSQQ; e.inv_dim = 1.f / 384; sync_after = false; break;
        case 5: kind = 1; g = {BIG + Z_CKV, WSB(W_UKV), T, 1024, 256, ZP}; e.O = R1; e.ldc = 1024; e.ssq = SSQKV; e.inv_dim = 1.f / 256; sync_after = false; break;
        case 6: kind = 4; layer = 0; break;
        case 7: kind = 5; break;
        case 8: kind = 3; rmode = 0; g = {R2, WSB(W_OUT0), T, D, D, D}; e.Xin = x_in; e.Xout = X; e.XB = XB; e.ssq_out = SSQ; break;
        case 9: kind = 1; g = {XB, WSB(W_XQ0), T, 512, D, D}; e.O = QX; e.ldc = 512; e.ssq = SSQ; e.inv_dim = 1.f / D; break;
        case 10: kind = 6; layer = 0; break;
        case 11: kind = 3; g = {OX, WSB(W_XO0), T, D, 512, 512}; e.Xin = X; e.Xout = X; e.XB = XB; e.ssq_out = SSQ; break;
        case 12: kind = 2; g = {XB, WSB(W_GU0), T, 2 * FF, D, D}; e.O = BIG; e.ldc = FF; e.ssq = SSQ; e.inv_dim = 1.f / D; break;
        case 13: kind = 3; g = {BIG, WSB(W_DN0), T, D, FF, FF}; e.Xin = X; e.Xout = X; e.XB = XB; e.ssq_out = SSQ; break;
        case 14: kind = 7; g = {XB, WSB(W_QKV), T, 3072, D, D}; e.O = BIG; e.ldc = 3072; e.ssq = SSQ; e.inv_dim = 1.f / D; e.rc = R64C; e.rs = R64S; e.rope_lo = 0; e.rope_hi = 8; break;
        case 15: sync_after = false; break;
        case 16: kind = 4; layer = 1; dil = 1; sync_after = false; break;
        case 17: kind = 4; layer = 1; dil = 4; break;
        case 18: kind = 4; layer = 1; dil = 16; break;
        case 19: kind = 3; g = {R1, WSB(W_OUT1), T, D, D, D}; e.Xin = X; e.Xout = X; e.XB = XB; e.ssq_out = SSQ; break;
        case 20: kind = 1; g = {XB, WSB(W_XQ1), T, 512, D, D}; e.O = QX; e.ldc = 512; e.ssq = SSQ; e.inv_dim = 1.f / D; break;
        case 21: kind = 6; layer = 1; break;
        case 22: kind = 3; g = {OX, WSB(W_XO1), T, D, 512, 512}; e.Xin = X; e.Xout = X; e.XB = XB; e.ssq_out = SSQ; break;
        case 23: kind = 2; g = {XB, WSB(W_GU1), T, 2 * FF, D, D}; e.O = BIG; e.ldc = FF; e.ssq = SSQ; e.inv_dim = 1.f / D; break;
        case 24: kind = 3; rmode = 2; g = {BIG, WSB(W_DN1), T, D, FF, FF}; e.Xin = X; e.Xout = X; e.XB = XB; e.ssq_out = SSQ; break;
        default: break;
        }
        if ((kind >= 1 && kind <= 3) || kind == 7) {
            pg8::StaticOrder SO; SO.init(g.M, g.N, G, bid);
            if (kind == 7) { pg8::EpiScaleRope E{e}; pg8::gemm_phase(lds, g, SO, E, tid); }
            else if (kind == 1) { pg8::EpiScale E{e}; pg8::gemm_phase(lds, g, SO, E, tid); }
            else if (kind == 2) { pg8::EpiSwiglu E{e}; pg8::gemm_phase(lds, g, SO, E, tid); }
            else if (rmode == 0) { pg8::EpiResid<0> E{e}; pg8::gemm_phase(lds, g, SO, E, tid); }
            else if (rmode == 1) { pg8::EpiResid<1> E{e}; pg8::gemm_phase(lds, g, SO, E, tid); }
            else { pg8::EpiResid<2> E{e}; pg8::gemm_phase(lds, g, SO, E, tid); }
        } else if (kind == 4) {
            const int nunits = layer == 0 ? 2048 : 4096;
            u32x4 sk[6], sv[6]; bool pre = false;
#pragma unroll
            for (int i = 0; i < 6; ++i) { sk[i] = (u32x4){0u, 0u, 0u, 0u}; sv[i] = (u32x4){0u, 0u, 0u, 0u}; }
            for (int u = vcu; u < nunits; u += G) {
                const bool hn = (u + G < nunits);
                const AttnArgs a = band_args(u, layer, dil, BIG, R1, R2, LSE1, LSE2, R64C, R64S, (const GAS float*)PIN(5));
                const AttnArgs an = band_args(hn ? u + G : u, layer, dil, BIG, R1, R2, LSE1, LSE2, R64C, R64S, (const GAS float*)PIN(5));
                attn_unit<64, 64, 8, 2, 1, true>(lds, a, tid, sk, sv, pre, hn, an);
                pre = hn;
            }
        } else if (kind == 5) {
            for (int rr = 0; rr < 8; ++rr) {
                int qb, bh;
                if (G == 256) { const int xcd = bid & 7, j = bid >> 3; bh = xcd * 8 + rr; qb = (rr & 1) ? 31 - j : j; }
                else { const int i = rr * G + ((rr & 1) ? (G - 1 - bid) : bid); if (i >= 2048) break; qb = 31 - (i >> 6); bh = i & 63; }
                const int b = bh >> 3, h = bh & 7;
                AttnArgs a{};
                a.rc = R32C; a.rs = R32S; a.scale2 = 0.10206207261596577f * LOG2E;
                a.Q = QB + h * 96; a.qpitch = 768; a.K1 = R1 + h * 128; a.k1pitch = 1024; a.K2 = BIG + Z_KR; a.k2pitch = ZP; a.V = R1 + h * 128 + 64; a.vpitch = 1024;
                a.O = R2 + 512 + h * 64; a.opitch = D; a.qrow0 = (long)b * S; a.kvrow0 = a.qrow0; a.dil = 1; a.q0 = qb * 256; a.W = 0;
                a.tlo = 0; a.thi = qb * 4 + 4; a.sink2 = -INFINITY; a.omode = 0; a.head = h;
                { u32x4 dk[6] = {}, dv[6] = {}; attn_unit<96, 64, 8, 1, 2, false, 128>(lds, a, tid, dk, dv, false, false, a); }
            }
        } else if (kind == 6) {
            for (int u = vcu; u < 1024; u += G) {
                const int qb = u & 31, h = (u >> 5) & 3, b = u >> 7;
                AttnArgs a{};
                a.scale2 = 0.08838834764831845f * LOG2E;
                a.Q = QX + h * 128; a.qpitch = 512; a.K1 = MEMKV + layer * 1024 + h * 128; a.k1pitch = 2048; a.K2 = a.K1; a.k2pitch = 2048; a.V = MEMKV + layer * 1024 + 512 + h * 128; a.vpitch = 2048;
                a.O = OX + h * 128; a.opitch = 512; a.qrow0 = (long)b * S; a.kvrow0 = (long)b * MEMLEN; a.dil = 1; a.q0 = qb * 256; a.W = 0;
                a.tlo = 0; a.thi = 4; a.sink2 = -INFINITY; a.omode = 0; a.head = h;
                { u32x4 dk[6] = {}, dv[6] = {}; attn_unit<128, 128, 16, 0, 0>(lds, a, tid, dk, dv, false, false, a); }
            }
        } else if (st == 0) {
            LAS float* scr = (LAS float*)(lds + wave * 16384);
#define WJOB(W_, ldw_, K_, g_, Bt_, roff_, rbs_, ncols_, nphys_) { constexpr int cnt = ((K_) / 64) * ((nphys_) / 32); \
        if (r < cnt) { wt_item((const GAS float*)(W_), ldw_, K_, (const GAS float*)(g_), Bt_, roff_, rbs_, ncols_, (nphys_) / 32, r, scr, lane); continue; } r -= cnt; }
#define WJOBP(W_, ldw_, K_, g_, Bt_, roff_, rbs_, ncols_, nphys_, plo_, phi_) { constexpr int cnt = ((K_) / 64) * ((nphys_) / 32); \
        if (r < cnt) { wt_item((const GAS float*)(W_), ldw_, K_, (const GAS float*)(g_), Bt_, roff_, rbs_, ncols_, (nphys_) / 32, r, scr, lane, plo_, phi_); continue; } r -= cnt; }
            constexpr int NITEMS = (1024 / 64) * (1536 / 32) + (384 / 64) * (768 / 32) + (256 / 64) * (1024 / 32) + 16 * 32 + 16 * 16 + 16 * 32 + 8 * 32 + 2 * 16 * 88 + 44 * 32
                                 + 16 * 96 + 16 * 32 + 16 * 16 + 16 * 32 + 8 * 32 + 2 * 16 * 88 + 44 * 32;
            for (int it = gw; it < NITEMS; it += NGW) {
                int r = it;
                WJOB(PIN(4), 1440, 1024, PIN(3), WSB(W_IN), 0, 128, 1440, 1536)
                WJOB(PIN(7), 768, 384, PIN(6), WSB(W_UQ), 0, 128, 768, 768)
                WJOB(PIN(9), 1024, 256, PIN(8), WSB(W_UKV), 0, 128, 1024, 1024)
                WJOB(PIN(10), 1024, 1024, nullptr, WSB(W_OUT0), 0, 128, 1024, 1024)
                WJOB(PIN(13), 512, 1024, PIN(11), WSB(W_XQ0), 0, 128, 512, 512)
                WJOB(PIN(14), 1024, 1024, PIN(12), WSB(W_XKV), 0, 128, 1024, 1024)
                WJOB(PIN(15), 1024, 512, nullptr, WSB(W_XO0), 0, 128, 1024, 1024)
                WJOB(PIN(17), FF, 1024, PIN(16), WSB(W_GU0), 0, 256, FF, FF)
                WJOB(PIN(18), FF, 1024, PIN(16), WSB(W_GU0), 128, 256, FF, FF)
                WJOB(PIN(19), 1024, FF, nullptr, WSB(W_DN0), 0, 128, 1024, 1024)
                WJOBP(PIN(21), 3072, 1024, PIN(20), WSB(W_QKV), 0, 128, 3072, 3072, 0, 2048)
                WJOB(PIN(22), 1024, 1024, nullptr, WSB(W_OUT1), 0, 128, 1024, 1024)
                WJOB(PIN(25), 512, 1024, PIN(23), WSB(W_XQ1), 0, 128, 512, 512)
                WJOB(PIN(26), 1024, 1024, PIN(24), WSB(W_XKV), 1024, 128, 1024, 1024)
                WJOB(PIN(27), 1024, 512, nullptr, WSB(W_XO1), 0, 128, 1024, 1024)
                WJOB(PIN(29), FF, 1024, PIN(28), WSB(W_GU1), 0, 256, FF, FF)
                WJOB(PIN(30), FF, 1024, PIN(28), WSB(W_GU1), 128, 256, FF, FF)
                WJOB(PIN(31), 1024, FF, nullptr, WSB(W_DN1), 0, 128, 1024, 1024)
            }
#undef WJOB
#undef WJOBP
            for (int idx = bid * 512 + tid; idx < T * 32; idx += G * 512) {
                const int t = idx >> 5, i = idx & 31;
                const float invf = exp2f(-(float)i * (13.287712379549449f / 32.0f));
                const float af = (float)pos_in[t] * invf;
                float s, c; sincosf(af, &s, &c);
                R64C[idx] = c; R64S[idx] = s;
                if (!(i & 1)) { R32C[t * 16 + (i >> 1)] = c; R32S[t * 16 + (i >> 1)] = s; }
            }
            for (int m0 = gw; m0 < T; m0 += 4 * NGW) {
                f32x4 v[4][4];
#pragma unroll
                for (int r = 0; r < 4; ++r)
#pragma unroll
                    for (int j = 0; j < 4; ++j) v[r][j] = *((const GAS f32x4*)(x_in + (size_t)(m0 + r * NGW) * D) + lane + 64 * j);
#pragma unroll
                for (int r = 0; r < 4; ++r) { const int m = m0 + r * NGW; float s = 0.f;
#pragma unroll
                    for (int j = 0; j < 4; ++j) s += (v[r][j][0] * v[r][j][0] + v[r][j][1] * v[r][j][1]) + (v[r][j][2] * v[r][j][2] + v[r][j][3] * v[r][j][3]);
                    s = wave_sum(s);
                    GAS u32x2* o8 = (GAS u32x2*)(XB + (size_t)m * D) + lane;
#pragma unroll
                    for (int j = 0; j < 4; ++j) { u32x2 w; w.x = cvtpk(v[r][j][0], v[r][j][1]); w.y = cvtpk(v[r][j][2], v[r][j][3]); o8[64 * j] = w; }
                    if (lane < 16) SSQ[(size_t)m * 16 + lane] = lane == 0 ? s : 0.f; }
            }
            for (int m = gw; m < MROWS; m += NGW) row_to_bf16(mem_in + (size_t)m * D, MEMB + (size_t)m * D, MEMSSQ + (size_t)m * 16, lane);
        } else if (st == 3) {
            for (int t0 = gw; t0 < T; t0 += 4 * NGW) {
                u32x4 vq[4], vk[4], a1[4], a2[4]; f32x4 c0[4], c1[4], s0[4], s1[4];
                const int role = lane < 8 ? 0 : (lane < 10 ? 1 : 2);
                const int hd = (lane >> 2) & 1, q = lane & 3, q2 = lane & 1;
#pragma unroll
                for (int r = 0; r < 4; ++r) { const int t = t0 + r * NGW; GAS bf16_t* zr = BIG + (size_t)t * ZP;
                    vq[r] = *(const GAS u32x4*)(zr + Z_CQ + 8 * (lane < 48 ? lane : 0));
                    vk[r] = *(const GAS u32x4*)(zr + Z_CKV + 8 * (lane & 31));
                    const GAS bf16_t* p1 = role == 1 ? zr + Z_KR + 8 * q2 : zr + Z_KA + hd * 64 + 8 * q;
                    a1[r] = *(const GAS u32x4*)p1; a2[r] = *(const GAS u32x4*)(p1 + (role == 1 ? 16 : 32));
                    const GAS float* cb = role == 1 ? R32C + (size_t)t * 16 + 8 * q2 : R64C + (size_t)t * 32 + 8 * q;
                    const GAS float* sb = role == 1 ? R32S + (size_t)t * 16 + 8 * q2 : R64S + (size_t)t * 32 + 8 * q;
                    c0[r] = *(const GAS f32x4*)cb; c1[r] = *(const GAS f32x4*)(cb + 4); s0[r] = *(const GAS f32x4*)sb; s1[r] = *(const GAS f32x4*)(sb + 4); }
#pragma unroll
                for (int r = 0; r < 4; ++r) { const int t = t0 + r * NGW; GAS bf16_t* zr = BIG + (size_t)t * ZP;
                    float f[8]; unpack8(vq[r], f); float sq = 0.f;
#pragma unroll
                    for (int j = 0; j < 8; ++j) sq += f[j] * f[j];
                    sq = lane < 48 ? sq : 0.f;
                    unpack8(vk[r], f); float sk = 0.f;
#pragma unroll
                    for (int j = 0; j < 8; ++j) sk += f[j] * f[j];
                    sk = lane < 32 ? sk : 0.f;
                    sq = wave_sum(sq); sk = wave_sum(sk);
                    if (lane < 16) { SSQQ[(size_t)t * 16 + lane] = lane == 0 ? sq : 0.f; SSQKV[(size_t)t * 16 + lane] = lane == 0 ? sk : 0.f; }
                    if (role < 2) {
                        float x1[8], x2[8], y1[8], y2[8]; unpack8(a1[r], x1); unpack8(a2[r], x2);
#pragma unroll
                        for (int j = 0; j < 8; ++j) { const float c = j < 4 ? c0[r][j & 3] : c1[r][j & 3], s = j < 4 ? s0[r][j & 3] : s1[r][j & 3]; y1[j] = x1[j] * c - x2[j] * s; y2[j] = x2[j] * c + x1[j] * s; }
                        GAS bf16_t* p1 = role == 1 ? zr + Z_KR + 8 * q2 : zr + Z_KA + hd * 64 + 8 * q;
                        *(GAS bf16x8*)p1 = pack8(y1); *(GAS bf16x8*)(p1 + (role == 1 ? 16 : 32)) = pack8(y2);
                    }
                }
            }
        } else if (st == 25) {
            const GAS float* gfin = (const GAS float*)PIN(32);
            const GAS _Float16* X16 = (const GAS _Float16*)WSB(O_OB);
            typedef _Float16 f16x8 __attribute__((ext_vector_type(8)));
            f32x4 gv[2][2];
#pragma unroll
            for (int j = 0; j < 2; ++j) { gv[j][0] = *(const GAS f32x4*)(gfin + j * 512 + 8 * lane); gv[j][1] = *(const GAS f32x4*)(gfin + j * 512 + 8 * lane + 4); }
            for (int t0 = gw; t0 < T; t0 += 4 * NGW) {
                f16x8 h[4][2]; f32x4 pr[4][4];
#pragma unroll
                for (int r = 0; r < 4; ++r) { const int t = t0 + r * NGW;
#pragma unroll
                    for (int j = 0; j < 2; ++j) h[r][j] = *(const GAS f16x8*)(X16 + (size_t)t * D + j * 512 + 8 * lane);
#pragma unroll
                    for (int j = 0; j < 4; ++j) pr[r][j] = *(const GAS f32x4*)(SSQ + (size_t)t * 16 + 4 * j); }
#pragma unroll
                for (int r = 0; r < 4; ++r) { const int t = t0 + r * NGW;
                    float s = 0.f;
#pragma unroll
                    for (int j = 0; j < 4; ++j) s += (pr[r][j][0] + pr[r][j][1]) + (pr[r][j][2] + pr[r][j][3]);
                    const float rs = __builtin_amdgcn_rsqf(s * (1.f / D) + EPS);
#pragma unroll
                    for (int j = 0; j < 2; ++j) {
                        const f32x4 v0 = (f32x4){(float)h[r][j][0], (float)h[r][j][1], (float)h[r][j][2], (float)h[r][j][3]} * rs * gv[j][0];
                        const f32x4 v1 = (f32x4){(float)h[r][j][4], (float)h[r][j][5], (float)h[r][j][6], (float)h[r][j][7]} * rs * gv[j][1];
                        GAS float* op = X + (size_t)t * D + j * 512 + 8 * lane;
                        *(GAS f32x4*)op = v0; *(GAS f32x4*)(op + 4) = v1; }
                }
            }
        }
        if ((sync_after || (REPEAT_MASK >> st) & 1u) && st + 1 < P.hi) {
            xcd_barrier(xbar);
        }
    }
}

constexpr int LDS_BYTES = 163840;
constexpr int NSTEPS = 26;

extern "C" void kernel_launch(void* const* d_in, const int* in_sizes, int n_in, void* d_out, int out_size, void* d_ws, size_t ws_size, hipStream_t stream) {
    static int grid_blocks = 0;
    if (!grid_blocks) {
        if (n_in != 33 || out_size != T * D || ws_size < WS_NEED * MiB) { fprintf(stderr, "kernel_launch: unexpected shapes n_in=%d out=%d ws=%zu\n", n_in, out_size, ws_size); grid_blocks = -1; return; }
        int dev = 0, cus = 0, per_cu = 0;
        hipGetDevice(&dev);
        hipDeviceGetAttribute(&cus, hipDeviceAttributeMultiprocessorCount, dev);
        hipFuncSetAttribute((const void*)fwd_kernel, hipFuncAttributeMaxDynamicSharedMemorySize, LDS_BYTES);
        hipOccupancyMaxActiveBlocksPerMultiprocessor(&per_cu, (const void*)fwd_kernel, 512, LDS_BYTES);
        if (per_cu < 1) per_cu = 1;
        grid_blocks = cus * per_cu;
        (void)hipGetLastError();
    }
    if (grid_blocks < 0) return;
    Params p{};
    for (int i = 0; i < 33; ++i) p.in[i] = d_in[i];
    p.out = (float*)d_out; p.ws = (unsigned char*)d_ws; p.lo = 0; p.hi = NSTEPS;
    (void)hipMemsetAsync(d_ws, 0, 16384, stream);
    void* args[] = {&p};
    hipError_t e = hipLaunchCooperativeKernel((const void*)fwd_kernel, dim3(grid_blocks), dim3(512), args, LDS_BYTES, stream);
    if (e != hipSuccess) fprintf(stderr, "cooperative launch failed: %s (grid %d)\n", hipGetErrorString(e), grid_blocks);
}
```
